# Optimizing an MI355X kernel written in HIP

```python
import jax, jax.numpy as jnp
from jax import lax
import numpy as np

D_MODEL = 1024
BATCH = 4
SEQ = 8192
DEPTH = 1

CHUNK = 64
Q_BLOCK = 128
PLE_DIM = 256
GLA_HEADS = 4
GLA_DK = D_MODEL // 8
GLA_DV = D_MODEL // 4
GLA_LOWRANK = 16
GLA_TAU = 16.0
SB_HEADS = 8
SB_DH = D_MODEL // 8
GLA_QK = GLA_HEADS * GLA_DK
GLA_V = GLA_HEADS * GLA_DV
SB_W = SB_HEADS * SB_DH
EPS = 1e-6

kernel_name = "hybrid_gla_stickbreak_gated_block"


def _split_sizes():
    return [GLA_QK, GLA_QK, GLA_V, GLA_LOWRANK, GLA_V, SB_W, SB_W, SB_W, SB_W, D_MODEL, D_MODEL]


def _d_in():
    return sum(_split_sizes())


def rmsnorm(x, g):
    xf = x.astype(jnp.float32)
    y = xf * lax.rsqrt(jnp.mean(xf * xf, axis=-1, keepdims=True) + EPS)
    return (y * g.astype(jnp.float32)).astype(x.dtype)


def gla_mixer(q, k, v, log_a):
    B, S, H, dk = q.shape
    dv = v.shape[-1]
    n = S // CHUNK

    def to_chunks(t):
        return t.reshape(B, n, CHUNK, H, t.shape[-1]).transpose(1, 0, 3, 2, 4)

    qc = to_chunks(q.astype(jnp.float32) * (dk ** -0.5))
    kc = to_chunks(k.astype(jnp.float32))
    vc = to_chunks(v.astype(jnp.float32))
    bc = jnp.cumsum(to_chunks(log_a.astype(jnp.float32)), axis=3)
    causal = jnp.tril(jnp.ones((CHUNK, CHUNK), dtype=bool))

    def step(state, inp):
        q_, k_, v_, b_ = inp
        eb, enb = jnp.exp(b_), jnp.exp(-b_)
        qd, kd = q_ * eb, k_ * enb
        qi, ki = q_ * enb, k_ * eb
        a_past = jnp.einsum('bhtd,bhsd->bhts', qd, kd)
        a_fut = jnp.einsum('bhtd,bhsd->bhts', qi, ki)
        attn = jnp.where(causal, a_past, a_fut)
        o = jnp.einsum('bhts,bhsv->bhtv', attn, v_) + jnp.einsum('bhtd,bhdv->bhtv', qd, state)
        b_last = b_[:, :, -1:, :]
        k_end = k_ * jnp.exp(b_last - b_)
        state = state * jnp.exp(b_last)[:, :, 0, :, None] + jnp.einsum('bhsd,bhsv->bhdv', k_end, v_)
        return state, o

    state0 = jnp.zeros((B, H, dk, dv), jnp.float32)
    _, o = lax.scan(step, state0, (qc, kc, vc, bc))
    return o.transpose(1, 0, 3, 2, 4).reshape(B, S, H, dv)


def stick_breaking(q, k, v):
    B, S, H, d = q.shape
    nb = S // Q_BLOCK
    qb = q.reshape(B, nb, Q_BLOCK, H, d).transpose(1, 0, 3, 2, 4)
    kt = k.transpose(0, 2, 1, 3)
    vt = v.transpose(0, 2, 1, 3)
    key_pos = jnp.arange(S)
    scale = d ** -0.5

    def block(args):
        qblk, i = args
        z = jnp.einsum('bhtd,bhsd->bhts', qblk, kt).astype(jnp.float32) * scale
        q_pos = i * Q_BLOCK + jnp.arange(Q_BLOCK)
        mask = key_pos[None, :] < q_pos[:, None]
        log_1m = jnp.where(mask, jax.nn.log_sigmoid(-z), 0.0)
        after = lax.cumsum(log_1m, axis=3, reverse=True) - log_1m
        w = jnp.where(mask, jnp.exp(jax.nn.log_sigmoid(z) + after), 0.0)
        return jnp.einsum('bhts,bhsd->bhtd', w.astype(vt.dtype), vt)

    o = lax.map(block, (qb, jnp.arange(nb)))
    return o.transpose(1, 0, 3, 2, 4).reshape(B, S, H, d)


def setup_inputs(seed: int = 0) -> dict:
    key = jax.random.key(seed)
    ks = jax.random.split(key, 16)
    d_in = _d_in()
    f32 = jnp.float32

    def nrm(k, shape, fan_in):
        return jax.random.normal(k, shape, f32) * (fan_in ** -0.5)

    def gain(k, shape):
        return 1.0 + 0.05 * jax.random.normal(k, shape, f32)

    return {
        "x": jax.random.normal(ks[0], (BATCH, SEQ, D_MODEL), f32),
        "p": jax.random.normal(ks[1], (DEPTH, BATCH, SEQ, PLE_DIM), f32),
        "g_mix": gain(ks[2], (DEPTH, D_MODEL)),
        "w_in": nrm(ks[3], (DEPTH, D_MODEL, d_in), D_MODEL),
        "w_alpha": nrm(ks[4], (DEPTH, GLA_LOWRANK, GLA_QK), GLA_LOWRANK),
        "b_alpha": 0.5 + 0.1 * jax.random.normal(ks[5], (DEPTH, GLA_QK), f32),
        "g_gla_out": gain(ks[6], (DEPTH, GLA_HEADS, GLA_DV)),
        "w_out_gla": nrm(ks[7], (DEPTH, GLA_V, D_MODEL), GLA_V),
        "w_out_sb": nrm(ks[8], (DEPTH, SB_W, D_MODEL), SB_W),
        "w_out": nrm(ks[9], (DEPTH, D_MODEL, D_MODEL), D_MODEL),
        "g_ple": gain(ks[10], (DEPTH, D_MODEL)),
        "w_ple_gate": nrm(ks[11], (DEPTH, D_MODEL, D_MODEL), D_MODEL),
        "w_ple": nrm(ks[12], (DEPTH, PLE_DIM, D_MODEL), PLE_DIM),
        "g_final": gain(ks[13], (D_MODEL,)),
    }


def reference(x, p, g_mix, w_in, w_alpha, b_alpha, g_gla_out, w_out_gla, w_out_sb, w_out,
              g_ple, w_ple_gate, w_ple, g_final):
    B, S, _ = x.shape
    sizes = _split_sizes()
    points = []
    acc = 0
    for s_ in sizes[:-1]:
        acc += s_
        points.append(acc)
    for i in range(DEPTH):
        h = rmsnorm(x, g_mix[i])
        z = jnp.einsum('bsd,de->bse', h, w_in[i])
        (q_a, k_a, v_a, lr_a, gate_a, q_b, k_b, v_b, gate_b, m_a, m_b) = jnp.split(z, points, axis=-1)

        log_a = jax.nn.log_sigmoid(
            (jnp.einsum('bsr,re->bse', lr_a, w_alpha[i]) + b_alpha[i]).astype(jnp.float32)) / GLA_TAU
        o_a = gla_mixer(q_a.reshape(B, S, GLA_HEADS, GLA_DK),
                        k_a.reshape(B, S, GLA_HEADS, GLA_DK),
                        v_a.reshape(B, S, GLA_HEADS, GLA_DV),
                        log_a.reshape(B, S, GLA_HEADS, GLA_DK))
        o_a = rmsnorm(o_a, g_gla_out[i]).astype(x.dtype).reshape(B, S, GLA_V)
        y_a = jnp.einsum('bse,ed->bsd', o_a * jax.nn.silu(gate_a), w_out_gla[i])

        o_b = stick_breaking(q_b.reshape(B, S, SB_HEADS, SB_DH),
                             k_b.reshape(B, S, SB_HEADS, SB_DH),
                             v_b.reshape(B, S, SB_HEADS, SB_DH)).reshape(B, S, SB_W)
        y_b = jnp.einsum('bse,ed->bsd', o_b * jax.nn.silu(gate_b), w_out_sb[i])

        merged = jax.nn.sigmoid(m_a) * y_a + jax.nn.sigmoid(m_b) * y_b
        x = x + jnp.einsum('bsd,de->bse', merged, w_out[i])

        u = rmsnorm(x, g_ple[i])
        gate_p = jax.nn.sigmoid(jnp.einsum('bsd,de->bse', u, w_ple_gate[i]))
        x = x + gate_p * jnp.einsum('bsp,pd->bsd', p[i], w_ple[i])
    return rmsnorm(x, g_final)
```

```cpp
#include <hip/hip_runtime.h>
#include <hip/hip_cooperative_groups.h>
#include <cstdio>
#include <cstdint>
namespace cg = cooperative_groups;
namespace pg8 {
#define PG8_LAS __attribute__((address_space(3)))
typedef unsigned short bf16_t;
typedef short bf16x8 __attribute__((ext_vector_type(8)));
typedef float f32x4 __attribute__((ext_vector_type(4)));
typedef unsigned u32x4 __attribute__((ext_vector_type(4)));
constexpr int BM = 256, BK = 64, HALF = 128, HTB = HALF * BK * 2  , STAGE_BYTES = 8 * HTB, NXCD = 8, WGM = 8;

__host__ __device__ __forceinline__ int lds_byte(int r, int c) { const int st = (r >> 4) * 2 + (c >> 5), rr = r & 15, cc = c & 31, ob = rr * 64 + cc * 2; return st * 1024 + (ob ^ (((ob >> 9) & 1) << 5)); }
__host__ __device__ __forceinline__ void stage_rc(int b, int& R, int& C) { const int st = b / 1024, sb = b % 1024, swz = sb ^ (((sb >> 9) & 1) << 5); R = (st >> 1) * 16 + swz / 64; C = (st & 1) * 32 + (swz % 64) / 2; }
__host__ __device__ __forceinline__ int perm32(int rho) { const int n = rho >> 4, i = rho & 15; return 8 * (i >> 2) + 4 * n + (i & 3); }

struct Unit { int pm, pn, sel; };
struct Gemm { const bf16_t* A; const bf16_t* Bt; const bf16_t* A2; const bf16_t* Bt2; int M, N, K, lda; };

struct StaticOrder {
    int nM, nN, nwg, G, c;
    __host__ __device__ void init(int M, int N, int G_, int c_) { nM = M / BM; nN = N / BM; nwg = nM * nN; G = G_; c = c_; }
    __host__ __device__ bool next(int i, Unit& u) const {
        const long L = (long)i * G + c; if (L >= nwg) return false;
        int wgid = (int)L; { const int q = nwg / NXCD, r = nwg % NXCD, xcd = wgid % NXCD, off = wgid / NXCD; wgid = (xcd < r ? xcd * (q + 1) : r * (q + 1) + (xcd - r) * q) + off; }
        const int nig = WGM * nN, gid = wgid / nig, fm = gid * WGM, gsz = (nM - fm) < WGM ? (nM - fm) : WGM;
        u.pm = fm + ((wgid % nig) % gsz); u.pn = (wgid % nig) / gsz; u.sel = 0; return true;
    }
    __device__ __forceinline__ void a_ready(const Unit&) const {}
    __device__ __forceinline__ void done(const Unit&) const {}
};

__device__ __forceinline__ unsigned cvt_pk_bf16(float lo, float hi) { unsigned r; asm volatile("v_cvt_pk_bf16_f32 %0, %1, %2" : "=v"(r) : "v"(lo), "v"(hi)); return r; }
typedef float f32x2 __attribute__((ext_vector_type(2)));
__device__ __forceinline__ f32x2 gelu_pk(f32x2 v) {
    const f32x2 av = __builtin_elementwise_abs(v), d = av * 0.2316418882f + 1.0f;
    f32x2 t; t.x = __builtin_amdgcn_rcpf(d.x); t.y = __builtin_amdgcn_rcpf(d.y);
    f32x2 q = t * 0.5307027145f + (-0.7265760135f); q = q * t + 0.7107068705f; q = q * t + (-0.142248368f); q = q * t + 0.127414796f; q = q * t;
    const f32x2 s = (v * v) * (-0.72134752044f);
    f32x2 e; e.x = __builtin_amdgcn_exp2f(s.x); e.y = __builtin_amdgcn_exp2f(s.y);
    const f32x2 m = v * (q * e), r = v - m;
    f32x2 o; o.x = v.x < 0.f ? m.x : r.x; o.y = v.y < 0.f ? m.y : r.y; return o;
}

template <int ACT  > struct EpiBf16 {
    static constexpr bool PERM = true, AFTER_DRAIN = false; static_assert(ACT == 0 || ACT == 1, "EpiBf16: ACT is 0 (none) or 1 (gelu_pk)");
    bf16_t* O; int ldc; const float* bias; int split_cols; size_t split_stride; float scale0;
    __device__ __forceinline__ void operator()(const f32x4 (&acc)[2][2][4][2], const Unit& u, int wr, int wc, int fr, int fq) const {
        const int row0 = u.pm * BM + wr * 64 + fr; int colt = u.pn * BM; bf16_t* base = O;
        float sc = 1.f; if (split_cols) { const int t = colt / split_cols; base += (size_t)t * split_stride; colt -= t * split_cols; if (t == 0) sc = scale0; }
        const int col0 = colt + wc * 32 + 8 * fq, bcol0 = u.pn * BM + wc * 32 + 8 * fq;
        f32x4 bv[2][2];
#pragma unroll
        for (int bj = 0; bj < 2; ++bj)
#pragma unroll
            for (int n = 0; n < 2; ++n) bv[bj][n] = bias ? *(const f32x4*)(bias + bcol0 + bj * HALF + 4 * n) : (f32x4){0.f, 0.f, 0.f, 0.f};
#pragma unroll
        for (int ai = 0; ai < 2; ++ai)
#pragma unroll
            for (int m = 0; m < 4; ++m) { bf16_t* rowp = base + (size_t)(row0 + ai * HALF + m * 16) * ldc + col0;
#pragma unroll
                for (int bj = 0; bj < 2; ++bj) { f32x4 v0 = acc[ai][bj][m][0] + bv[bj][0], v1 = acc[ai][bj][m][1] + bv[bj][1];
                    if (ACT == 1) { f32x2 a = gelu_pk((f32x2){v0[0], v0[1]}), b = gelu_pk((f32x2){v0[2], v0[3]}), c = gelu_pk((f32x2){v1[0], v1[1]}), d = gelu_pk((f32x2){v1[2], v1[3]});
                        v0 = (f32x4){a.x, a.y, b.x, b.y}; v1 = (f32x4){c.x, c.y, d.x, d.y}; }
                    v0 = v0 * sc; v1 = v1 * sc; u32x4 w; w.x = cvt_pk_bf16(v0[0], v0[1]); w.y = cvt_pk_bf16(v0[2], v0[3]); w.z = cvt_pk_bf16(v1[0], v1[1]); w.w = cvt_pk_bf16(v1[2], v1[3]);
                    *(u32x4*)(rowp + bj * HALF) = w; } }
    }
};

struct PanelStats {
    unsigned* xbuf;
    unsigned* cnt;
    unsigned* tmo;
    int ntn; float eps;
    unsigned code;
    __device__ __forceinline__ bool run(const f32x4 (&v)[2][2][4][2], const Unit& u, int wr, int wc, int fr, int fq, PG8_LAS unsigned char* lds, int wid, int lane) const {
        typedef float f32x2v __attribute__((ext_vector_type(2)));
        PG8_LAS f32x2v* P = (PG8_LAS f32x2v*)lds;
        PG8_LAS f32x2v* S = (PG8_LAS f32x2v*)(lds + 8192);
        PG8_LAS unsigned* flag = (PG8_LAS unsigned*)(lds + 8192 + 2048);
#pragma unroll
        for (int ai = 0; ai < 2; ++ai)
#pragma unroll
            for (int m = 0; m < 4; ++m) {
                float s = 0.f;
#pragma unroll
                for (int bj = 0; bj < 2; ++bj)
#pragma unroll
                    for (int n = 0; n < 2; ++n) { const f32x4 x = v[ai][bj][m][n]; s += (x[0] + x[1]) + (x[2] + x[3]); }
                s += __shfl_xor(s, 16); s += __shfl_xor(s, 32);
                const float mw = s * (1.0f / 64.0f); float q = 0.f;
#pragma unroll
                for (int bj = 0; bj < 2; ++bj)
#pragma unroll
                    for (int n = 0; n < 2; ++n) { const f32x4 d = v[ai][bj][m][n] - mw; q += (d[0] * d[0] + d[1] * d[1]) + (d[2] * d[2] + d[3] * d[3]); }
                q += __shfl_xor(q, 16); q += __shfl_xor(q, 32);
                if (fq == 0) P[(ai * HALF + wr * 64 + m * 16 + fr) * 4 + wc] = (f32x2v){mw, q};
            }
        asm volatile("s_waitcnt lgkmcnt(0)" ::: "memory"); __builtin_amdgcn_s_barrier(); asm volatile("" ::: "memory");
#if defined(BROKEN_EXCHANGE_NO_WAIT)
#warning BROKEN CONTROL BUILD: the row-statistics exchange does not wait; results are wrong by design
        if (blockIdx.x >= 64) { const long long t0_ = clock64(); while (clock64() - t0_ < 60000) __builtin_amdgcn_s_sleep(8); }
#endif
        const int row = wid * 32 + (lane & 31);
        if (lane < 32) {
            const f32x2v a = P[row * 4 + 0], b = P[row * 4 + 1], c = P[row * 4 + 2], d = P[row * 4 + 3];
            const float mt = (a.x + b.x + c.x + d.x) * 0.25f;
            const float da = a.x - mt, db = b.x - mt, dc = c.x - mt, dd = d.x - mt;
            const float m2 = (a.y + b.y) + (c.y + d.y) + 64.0f * ((da * da + db * db) + (dc * dc + dd * dd));
            unsigned long long* slot = (unsigned long long*)xbuf + ((size_t)(u.pm * BM + row) * 4 + u.pn);
            __hip_atomic_store(slot, ((unsigned long long)__float_as_uint(m2) << 32) | __float_as_uint(mt), __ATOMIC_RELAXED, __HIP_MEMORY_SCOPE_AGENT);
        }
        asm volatile("s_waitcnt vmcnt(0)" ::: "memory");
        if (lane == 0) __hip_atomic_fetch_add(cnt + 64 * u.pm, 1u, __ATOMIC_RELAXED, __HIP_MEMORY_SCOPE_AGENT);
        if (wid == 0) {
            bool dead = false; const unsigned long long t0 = __builtin_amdgcn_s_memrealtime(); const unsigned want = 8u * (unsigned)ntn;
            for (;;) {
#if defined(BROKEN_EXCHANGE_NO_WAIT)
                break;
#endif
                if ((unsigned)__builtin_amdgcn_readfirstlane(__hip_atomic_load(cnt + 64 * u.pm, __ATOMIC_RELAXED, __HIP_MEMORY_SCOPE_AGENT)) >= want) break;
                if (__builtin_amdgcn_s_memrealtime() - t0 > 2000000ull) {
                    if (lane == 0) { unsigned expect = 0u; __hip_atomic_compare_exchange_strong(tmo + 1, &expect, code | (unsigned)(u.pm & 0xff), __ATOMIC_RELAXED, __ATOMIC_RELAXED, __HIP_MEMORY_SCOPE_AGENT);
                                     __hip_atomic_store(tmo, 1u, __ATOMIC_RELAXED, __HIP_MEMORY_SCOPE_AGENT); }
                    dead = true; break; }
                __builtin_amdgcn_s_sleep(2);
            }
            __builtin_amdgcn_fence(__ATOMIC_ACQUIRE, "agent");
            if (lane == 0) flag[0] = dead ? 1u : 0u;
        }
        asm volatile("s_waitcnt vmcnt(0) lgkmcnt(0)" ::: "memory"); __builtin_amdgcn_s_barrier(); asm volatile("" ::: "memory");
        const bool bad = flag[0] != 0u;
        if (lane < 32) {
            const unsigned long long* slot = (const unsigned long long*)xbuf + (size_t)(u.pm * BM + row) * 4; float mt[4], m2[4]; float ms = 0.f;
#pragma unroll
            for (int t = 0; t < 4; ++t) { if (t < ntn) { const unsigned long long w = __hip_atomic_load(slot + t, __ATOMIC_RELAXED, __HIP_MEMORY_SCOPE_AGENT); mt[t] = __uint_as_float((unsigned)w); m2[t] = __uint_as_float((unsigned)(w >> 32)); } else { mt[t] = 0.f; m2[t] = 0.f; } ms += mt[t]; }
            const float mean = ms / (float)ntn; float q = 0.f;
#pragma unroll
            for (int t = 0; t < 4; ++t) if (t < ntn) { const float dm = mt[t] - mean; q += m2[t] + 256.0f * dm * dm; }
            S[row] = (f32x2v){mean, 1.0f / sqrtf(q / (256.0f * (float)ntn) + eps)};
        }
        asm volatile("s_waitcnt lgkmcnt(0)" ::: "memory"); __builtin_amdgcn_s_barrier(); asm volatile("" ::: "memory");
        return bad;
    }
};
struct EpiLnRes {
    static constexpr bool PERM = false, AFTER_DRAIN = true;
    const float* base; float* out; int ldc; const float* bias; PanelStats st; unsigned poison;
    __device__ __forceinline__ void fused(f32x4 (&acc)[2][2][4][2], const Unit& u, int wr, int wc, int fr, int fq, PG8_LAS unsigned char* lds, int wid, int lane) const {
        typedef float f32x2v __attribute__((ext_vector_type(2)));
        const PG8_LAS f32x2v* S = (const PG8_LAS f32x2v*)(lds + 8192);
        const int col0 = u.pn * BM + wc * 32 + 4 * fq;
#pragma unroll
        for (int bj = 0; bj < 2; ++bj)
#pragma unroll
            for (int n = 0; n < 2; ++n) { const f32x4 bv = bias ? *(const f32x4*)(bias + col0 + bj * HALF + n * 16) : (f32x4){0.f, 0.f, 0.f, 0.f};
#pragma unroll
                for (int ai = 0; ai < 2; ++ai)
#pragma unroll
                    for (int m = 0; m < 4; ++m) acc[ai][bj][m][n] += bv; }
        f32x4 pre[4][2][2];
#pragma unroll
        for (int m = 0; m < 4; ++m) { const size_t off = (size_t)(u.pm * BM + wr * 64 + m * 16 + fr) * ldc + col0;
#pragma unroll
            for (int bj = 0; bj < 2; ++bj)
#pragma unroll
                for (int n = 0; n < 2; ++n) pre[m][bj][n] = *(const f32x4*)(base + off + bj * HALF + n * 16); }
        const bool bad = st.run(acc, u, wr, wc, fr, fq, lds, wid, lane) || poison != 0u;
        const float qnan = __builtin_nanf("");
#pragma unroll
        for (int ai = 0; ai < 2; ++ai)
#pragma unroll
            for (int m = 0; m < 4; ++m) { const int r = ai * HALF + wr * 64 + m * 16 + fr; const f32x2v sr = S[r]; const size_t off = (size_t)(u.pm * BM + r) * ldc + col0;
#pragma unroll
                for (int bj = 0; bj < 2; ++bj)
#pragma unroll
                    for (int n = 0; n < 2; ++n) { const f32x4 bs = ai == 0 ? pre[m][bj][n] : *(const f32x4*)(base + off + bj * HALF + n * 16); f32x4 o = bs + (acc[ai][bj][m][n] - sr.x) * sr.y;
                        if (bad) o = (f32x4){qnan, qnan, qnan, qnan}; *(f32x4*)(out + off + bj * HALF + n * 16) = o; }
                if (m & 1) asm volatile("" ::: "memory"); }
    }
};
struct EpiLnResLn {
    static constexpr bool PERM = false, AFTER_DRAIN = true;
    const float* base; float* out; bf16_t* xn; int ldc; const float* bias; PanelStats st1, st2; unsigned poison;
    __device__ __forceinline__ void fused(f32x4 (&acc)[2][2][4][2], const Unit& u, int wr, int wc, int fr, int fq, PG8_LAS unsigned char* lds, int wid, int lane) const {
        typedef float f32x2v __attribute__((ext_vector_type(2))); typedef unsigned u32x2v __attribute__((ext_vector_type(2)));
        const PG8_LAS f32x2v* S = (const PG8_LAS f32x2v*)(lds + 8192);
        const int col0 = u.pn * BM + wc * 32 + 4 * fq;
#pragma unroll
        for (int bj = 0; bj < 2; ++bj)
#pragma unroll
            for (int n = 0; n < 2; ++n) { const f32x4 bv = bias ? *(const f32x4*)(bias + col0 + bj * HALF + n * 16) : (f32x4){0.f, 0.f, 0.f, 0.f};
#pragma unroll
                for (int ai = 0; ai < 2; ++ai)
#pragma unroll
                    for (int m = 0; m < 4; ++m) acc[ai][bj][m][n] += bv; }
        bool bad = st1.run(acc, u, wr, wc, fr, fq, lds, wid, lane) || poison != 0u;
        const float qnan = __builtin_nanf("");
#pragma unroll
        for (int ai = 0; ai < 2; ++ai)
#pragma unroll
            for (int m = 0; m < 4; ++m) { const int r = ai * HALF + wr * 64 + m * 16 + fr; const f32x2v sr = S[r]; const size_t off = (size_t)(u.pm * BM + r) * ldc + col0;
#pragma unroll
                for (int bj = 0; bj < 2; ++bj)
#pragma unroll
                    for (int n = 0; n < 2; ++n) { const f32x4 bs = *(const f32x4*)(base + off + bj * HALF + n * 16); acc[ai][bj][m][n] = bs + (acc[ai][bj][m][n] - sr.x) * sr.y; }
                asm volatile("" : "+v"(acc[ai][0][m][0]), "+v"(acc[ai][0][m][1]), "+v"(acc[ai][1][m][0]), "+v"(acc[ai][1][m][1]));
                if (m & 1) asm volatile("" ::: "memory"); }
        const bool bad1 = bad;
        bad = st2.run(acc, u, wr, wc, fr, fq, lds, wid, lane) || bad;
#pragma unroll
        for (int ai = 0; ai < 2; ++ai)
#pragma unroll
            for (int m = 0; m < 4; ++m) { const int r = ai * HALF + wr * 64 + m * 16 + fr; const f32x2v sr = S[r]; const size_t off = (size_t)(u.pm * BM + r) * ldc + col0;
#pragma unroll
                for (int bj = 0; bj < 2; ++bj)
#pragma unroll
                    for (int n = 0; n < 2; ++n) { const f32x4 x1 = acc[ai][bj][m][n]; *(f32x4*)(out + off + bj * HALF + n * 16) = bad1 ? (f32x4){qnan, qnan, qnan, qnan} : x1;
                        const f32x4 o = (x1 - sr.x) * sr.y; u32x2v w; w.x = cvt_pk_bf16(o[0], o[1]); w.y = cvt_pk_bf16(o[2], o[3]);
                        if (bad) { w.x = 0x7fc07fc0u; w.y = 0x7fc07fc0u; } *(u32x2v*)(xn + off + bj * HALF + n * 16) = w; }
                asm volatile("" ::: "memory"); }
    }
};

template <class Epi, class Sched, bool ALIGN_EPI = false, bool SP2 = false>
__device__ __forceinline__ void gemm_phase(PG8_LAS unsigned char* lds, const Gemm g, const Sched& S, const Epi& E) {
    int tid_ = threadIdx.x; asm volatile("" : "+v"(tid_)); const int tid = tid_, wid = __builtin_amdgcn_readfirstlane(tid >> 6), lane = tid & 63, wr = wid >> 2, wc = wid & 3, fr = lane & 15, fq = lane >> 4;
    const int K = g.K, nt = K / BK;
    unsigned voffA[2], voffB[2];
#pragma unroll
    for (int i = 0; i < 2; ++i) { int R, C; stage_rc(tid * 16 + i * 8192, R, C); const int Rb = Epi::PERM ? ((R & ~31) + perm32(R & 31)) : R;
        voffA[i] = (unsigned)(R * g.lda + C) * 2u; voffB[i] = (unsigned)(Rb * K + C) * 2u; }
    const size_t kstep = (size_t)(BK * 2);
    const size_t hstepA = (size_t)HALF * g.lda * 2, hstepB = (size_t)HALF * K * 2;
    const size_t tstepA = 2 * hstepA, tstepB = 2 * hstepB;
    const unsigned ldsw = (unsigned)wid * 1024u;
    const int aoff = lds_byte(wr * 64 + fr, fq * 8), boff = lds_byte(wc * 32 + fr, fq * 8);
#define PG8_SA(b, h) (((b) * 2 + (h)) * HTB)
#define PG8_SB(b, h) ((4 + (b) * 2 + (h)) * HTB)
#define PG8_STAGE(bufoff, gbase, voff) do { _Pragma("unroll") for (int _i = 0; _i < 2; ++_i) \
        __builtin_amdgcn_global_load_lds((const unsigned*)((const char*)(gbase) + (voff)[_i]), (PG8_LAS unsigned*)(lds + (bufoff) + ldsw + _i * 8192), 16, 0, 0); } while (0)
#define PG8_LDA(dst, b, h) do { _Pragma("unroll") for (int m = 0; m < 4; ++m) _Pragma("unroll") for (int k = 0; k < 2; ++k) dst[m][k] = *(const PG8_LAS bf16x8*)(lds + PG8_SA(b, h) + aoff + m * 2048 + k * 1024); } while (0)
#define PG8_LDB(dst, b, h) do { _Pragma("unroll") for (int n = 0; n < 2; ++n) _Pragma("unroll") for (int k = 0; k < 2; ++k) dst[n][k] = *(const PG8_LAS bf16x8*)(lds + PG8_SB(b, h) + boff + n * 2048 + k * 1024); } while (0)
#define PG8_MMA(ai, bj, At, Bt) do { __builtin_amdgcn_s_setprio(1); _Pragma("unroll") for (int m = 0; m < 4; ++m) _Pragma("unroll") for (int n = 0; n < 2; ++n) _Pragma("unroll") for (int k = 0; k < 2; ++k) \
        acc[ai][bj][m][n] = __builtin_amdgcn_mfma_f32_16x16x32_bf16(Bt[n][k], At[m][k], acc[ai][bj][m][n], 0, 0, 0); __builtin_amdgcn_s_setprio(0); } while (0)
#define PG8_WAIT_V(n) asm volatile("s_waitcnt vmcnt(" #n ")" ::: "memory")
#define PG8_WAIT_L(n) asm volatile("s_waitcnt lgkmcnt(" #n ")" ::: "memory")
#define PG8_BAR __builtin_amdgcn_s_barrier()
#define PG8_SCHED __builtin_amdgcn_sched_barrier(0)
    Unit cur, nxt; int ui = 0;
    if (!S.next(0, cur)) return;
    f32x4 acc[2][2][4][2];
#pragma unroll
    for (int a = 0; a < 2; ++a)
#pragma unroll
        for (int b = 0; b < 2; ++b)
#pragma unroll
            for (int m = 0; m < 4; ++m)
#pragma unroll
                for (int n = 0; n < 2; ++n) acc[a][b][m][n] = (f32x4){0.f, 0.f, 0.f, 0.f};
    bf16x8 At[4][2], B0[2][2], B1[2][2];
    const char* cA = (const char*)(cur.sel ? g.A2 : g.A) + (size_t)cur.pm * tstepA; const char* cB = (const char*)(cur.sel ? g.Bt2 : g.Bt) + (size_t)cur.pn * tstepB;
    S.a_ready(cur);
    if constexpr (SP2) {
        PG8_STAGE(PG8_SB(0, 0), cB, voffB); PG8_STAGE(PG8_SB(0, 1), cB + hstepB, voffB); PG8_STAGE(PG8_SA(0, 0), cA, voffA); PG8_STAGE(PG8_SA(0, 1), cA + hstepA, voffA);
        if (wr == 1) PG8_BAR;
        PG8_WAIT_V(2); PG8_BAR;
        PG8_STAGE(PG8_SB(1, 0), cB + kstep, voffB); PG8_STAGE(PG8_SA(1, 0), cA + kstep, voffA); PG8_STAGE(PG8_SB(1, 1), cB + hstepB + kstep, voffB);
        PG8_WAIT_V(6); PG8_BAR;
    } else {
        PG8_STAGE(PG8_SB(0, 0), cB, voffB); PG8_STAGE(PG8_SA(0, 0), cA, voffA); PG8_STAGE(PG8_SB(0, 1), cB + hstepB, voffB); PG8_STAGE(PG8_SA(0, 1), cA + hstepA, voffA);
        if (wr == 1) PG8_BAR;
        PG8_WAIT_V(4); PG8_BAR;
        PG8_STAGE(PG8_SB(1, 0), cB + kstep, voffB); PG8_STAGE(PG8_SA(1, 0), cA + kstep, voffA); PG8_STAGE(PG8_SB(1, 1), cB + hstepB + kstep, voffB);
        PG8_WAIT_V(6); PG8_BAR;
    }
    for (;;) {
        const bool has_next = S.next(ui + 1, nxt);
        const char* nA = has_next ? (const char*)(nxt.sel ? g.A2 : g.A) + (size_t)nxt.pm * tstepA : cA; const char* nB = has_next ? (const char*)(nxt.sel ? g.Bt2 : g.Bt) + (size_t)nxt.pn * tstepB : cB;
        for (int t = 0; t < nt; t += 2) {
            const bool last = (t == nt - 2);
            const char* a1 = cA + (size_t)(t + 1) * kstep;
            const char* a2 = last ? nA : cA + (size_t)(t + 2) * kstep; const char* b2 = last ? nB : cB + (size_t)(t + 2) * kstep;
            const char* a3 = a2 + kstep; const char* b3 = b2 + kstep;
            if (last && has_next) S.a_ready(nxt);
            if constexpr (SP2) {
            PG8_LDB(B0, 0, 0); PG8_LDB(B1, 0, 1); PG8_SCHED; PG8_LDA(At, 0, 0); PG8_STAGE(PG8_SA(1, 1), a1 + hstepA, voffA);
            PG8_WAIT_V(8); PG8_WAIT_L(0); PG8_BAR; PG8_MMA(0, 0, At, B0); PG8_MMA(0, 1, At, B1); PG8_BAR; PG8_SCHED;
            PG8_LDA(At, 0, 1); PG8_STAGE(PG8_SB(0, 0), b2, voffB); PG8_STAGE(PG8_SB(0, 1), b2 + hstepB, voffB); PG8_STAGE(PG8_SA(0, 0), a2, voffA);
            PG8_WAIT_V(8); PG8_WAIT_L(0); PG8_BAR; PG8_MMA(1, 0, At, B0); PG8_MMA(1, 1, At, B1); PG8_BAR; PG8_SCHED;
            PG8_LDB(B0, 1, 0); PG8_LDB(B1, 1, 1); PG8_SCHED; PG8_LDA(At, 1, 0); PG8_STAGE(PG8_SA(0, 1), a2 + hstepA, voffA);
            PG8_WAIT_V(8); PG8_WAIT_L(0); PG8_BAR; PG8_MMA(0, 0, At, B0); PG8_MMA(0, 1, At, B1); PG8_BAR; PG8_SCHED;
            PG8_LDA(At, 1, 1); PG8_STAGE(PG8_SB(1, 0), b3, voffB); PG8_STAGE(PG8_SB(1, 1), b3 + hstepB, voffB); PG8_STAGE(PG8_SA(1, 0), a3, voffA);
            PG8_WAIT_V(8); PG8_WAIT_L(0); PG8_BAR; PG8_MMA(1, 0, At, B0); PG8_MMA(1, 1, At, B1); PG8_BAR; PG8_SCHED;
            } else {
            PG8_LDB(B0, 0, 0); PG8_SCHED; PG8_LDA(At, 0, 0); PG8_STAGE(PG8_SA(1, 1), a1 + hstepA, voffA);
            PG8_WAIT_L(8); PG8_BAR; PG8_WAIT_L(0); PG8_MMA(0, 0, At, B0); PG8_BAR; PG8_SCHED;
            PG8_LDB(B1, 0, 1); PG8_STAGE(PG8_SB(0, 0), b2, voffB);
            PG8_BAR; PG8_WAIT_L(0); PG8_MMA(0, 1, At, B1); PG8_BAR;
            PG8_LDA(At, 0, 1); PG8_STAGE(PG8_SA(0, 0), a2, voffA);
            PG8_BAR; PG8_WAIT_L(0); PG8_MMA(1, 0, At, B0); PG8_BAR; PG8_SCHED;
            PG8_STAGE(PG8_SB(0, 1), b2 + hstepB, voffB);
            PG8_WAIT_V(6); PG8_BAR; PG8_MMA(1, 1, At, B1); PG8_BAR;
            PG8_LDB(B0, 1, 0); PG8_SCHED; PG8_LDA(At, 1, 0); PG8_STAGE(PG8_SA(0, 1), a2 + hstepA, voffA);
            PG8_WAIT_L(8); PG8_BAR; PG8_WAIT_L(0); PG8_MMA(0, 0, At, B0); PG8_BAR; PG8_SCHED;
            PG8_LDB(B1, 1, 1); PG8_STAGE(PG8_SB(1, 0), b3, voffB);
            PG8_BAR; PG8_WAIT_L(0); PG8_MMA(0, 1, At, B1); PG8_BAR;
            PG8_LDA(At, 1, 1); PG8_STAGE(PG8_SA(1, 0), a3, voffA);
            PG8_BAR; PG8_WAIT_L(0); PG8_MMA(1, 0, At, B0); PG8_BAR; PG8_SCHED;
            PG8_STAGE(PG8_SB(1, 1), b3 + hstepB, voffB);
            PG8_WAIT_V(6); PG8_BAR; PG8_MMA(1, 1, At, B1); PG8_BAR;
            }
        }
        if constexpr (ALIGN_EPI) { if (wr == 0) PG8_BAR; }
        if constexpr (!Epi::AFTER_DRAIN) { E(acc, cur, wr, wc, fr, fq); S.done(cur); }
        if (!has_next) break;
#pragma unroll
        for (int a = 0; a < 2; ++a)
#pragma unroll
            for (int b = 0; b < 2; ++b)
#pragma unroll
                for (int m = 0; m < 4; ++m)
#pragma unroll
                    for (int n = 0; n < 2; ++n) acc[a][b][m][n] = (f32x4){0.f, 0.f, 0.f, 0.f};
        cur = nxt; cA = nA; cB = nB; ++ui;
        if constexpr (ALIGN_EPI) { if (wr == 1) PG8_BAR; }
    }
    PG8_WAIT_V(0);
    if constexpr (!ALIGN_EPI) { if (wr == 0) PG8_BAR; }
    PG8_BAR;
    if constexpr (Epi::AFTER_DRAIN) { E.fused(acc, cur, wr, wc, fr, fq, lds, wid, lane); S.done(cur); }
#undef PG8_SA
#undef PG8_SB
#undef PG8_STAGE
#undef PG8_LDA
#undef PG8_LDB
#undef PG8_MMA
#undef PG8_WAIT_V
#undef PG8_WAIT_L
#undef PG8_BAR
#undef PG8_SCHED
}
}
#define XB_TMO      128
#define XB_XCNT(j)  (256  + 64 * (j))
#define XB_XSUB(j)  (1280 + 64 * (j))
#define XB_XGEN(j)  (2304 + 64 * (j))
#define XB_TOP      3328
#define XB_TOPGEN   3392
#define XCD_BAR_WORDS 3456
#define XB_SPIN_CAP (1u << 18)

__device__ __forceinline__ unsigned xb_ld(unsigned* p)              { return __hip_atomic_load(p, __ATOMIC_RELAXED, __HIP_MEMORY_SCOPE_AGENT); }
__device__ __forceinline__ unsigned xb_add(unsigned* p, unsigned v) { return __hip_atomic_fetch_add(p, v, __ATOMIC_RELAXED, __HIP_MEMORY_SCOPE_AGENT); }
__device__ __forceinline__ unsigned xb_xcc_id() { return (unsigned)__builtin_amdgcn_s_getreg((3 << 11) | 20) & 0xFu; }
#define XB_SPIN(cond, bar) do { unsigned _sp = 0; while (cond) { __builtin_amdgcn_s_sleep(1); \
    if ((++_sp & 255u) == 0u) { if (xb_ld(&(bar)[XB_TMO])) break; if (_sp > XB_SPIN_CAP) { atomicAdd(&(bar)[XB_TMO], 1u); break; } } } } while (0)

struct XcdBarrier {
    unsigned* bar; unsigned x;
    volatile __attribute__((address_space(3))) unsigned* st;
};

__device__ __forceinline__ XcdBarrier xcd_barrier_post(unsigned* bar, volatile __attribute__((address_space(3))) unsigned* st) {
    XcdBarrier b; b.bar = bar; b.x = xb_xcc_id(); b.st = st;
    if (threadIdx.x == 0) (void)xb_add(&bar[XB_XCNT(b.x)], 1u);
    return b;
}
__device__ __forceinline__ void xcd_barrier_complete(unsigned* bar, unsigned x, unsigned& nloc, unsigned& nx) {
    const unsigned G = gridDim.x * gridDim.y * gridDim.z;
    unsigned sum, cnt, mine, sp = 0u;
    for (;;) {
        sum = 0u; cnt = 0u; mine = 0u;
#pragma unroll
        for (unsigned j = 0; j < 16; ++j) { const unsigned c = xb_ld(&bar[XB_XCNT(j)]); sum += c; cnt += (c > 0u) ? 1u : 0u; mine = (j == x) ? c : mine; }
        if (sum == G) break;
        __builtin_amdgcn_s_sleep(1);
        if ((++sp & 255u) == 0u) { if (xb_ld(&bar[XB_TMO])) break; if (sp > XB_SPIN_CAP) { atomicAdd(&bar[XB_TMO], 1u); break; } }
    }
    nloc = mine > 0u ? mine : 1u; nx = cnt > 0u ? cnt : 1u;
}

__device__ __forceinline__ void xcd_barrier(const XcdBarrier& b) {
    asm volatile("s_waitcnt vmcnt(0)" ::: "memory");
    __syncthreads();
    if (threadIdx.x == 0) {
        unsigned* bar = b.bar;
        __builtin_amdgcn_s_waitcnt(0);
        unsigned nloc = b.st[0], nx = b.st[1];
        if (nloc == 0u) { xcd_barrier_complete(bar, b.x, nloc, nx); b.st[0] = nloc; b.st[1] = nx; }
        const unsigned old = xb_add(&bar[XB_XSUB(b.x)], 1u);
        const unsigned gen = old / nloc;
        if (old + 1u == (gen + 1u) * nloc) {
            __builtin_amdgcn_fence(__ATOMIC_RELEASE, "agent");
            asm volatile("s_waitcnt vmcnt(0)" ::: "memory");
            const unsigned og = xb_add(&bar[XB_TOP], 1u);
            const unsigned tg = og / nx;
            if (og + 1u == (tg + 1u) * nx) xb_add(&bar[XB_TOPGEN], 1u);
            else XB_SPIN(xb_ld(&bar[XB_TOPGEN]) == tg, bar);
            __builtin_amdgcn_fence(__ATOMIC_ACQUIRE, "agent");
            xb_add(&bar[XB_XGEN(b.x)], 1u);
            asm volatile("s_waitcnt vmcnt(0)" ::: "memory");
        } else {
            XB_SPIN(xb_ld(&bar[XB_XGEN(b.x)]) == gen, bar);
            __builtin_amdgcn_fence(__ATOMIC_ACQUIRE, "agent");
            asm volatile("s_waitcnt vmcnt(0)" ::: "memory");
        }
    }
    __syncthreads();
}

#define LAS __attribute__((address_space(3)))
typedef unsigned short bf16_t;
typedef short bf16x8 __attribute__((ext_vector_type(8)));
typedef short s16x4 __attribute__((ext_vector_type(4)));
typedef float f32x4 __attribute__((ext_vector_type(4)));
typedef float f32x16 __attribute__((ext_vector_type(16)));
typedef unsigned u32x4 __attribute__((ext_vector_type(4)));
typedef unsigned u32x2 __attribute__((ext_vector_type(2)));

constexpr int NTOK = 32768, DM = 1024, SEQ = 8192, LDZ = 5120;
constexpr float EPS = 1e-6f;
constexpr size_t MiB = (size_t)1 << 20;
constexpr size_t WS_W1T = 1 * MiB, WS_W4T = 12 * MiB, WS_WG = 20 * MiB, WS_WS = 22 * MiB, WS_WO = 24 * MiB, WS_WPG = 26 * MiB, WS_WPE = 28 * MiB;
constexpr size_t WS_LR = 29 * MiB, WS_DEC = 31 * MiB, WS_H = 32 * MiB, WS_Z1 = 96 * MiB, WS_ATTN = 416 * MiB, WS_PB = 432 * MiB, WS_SSA = 448 * MiB, WS_SS1 = 456 * MiB, WS_SS2 = 458 * MiB;
constexpr size_t WS_X1F = 96 * MiB, WS_X1B = 224 * MiB, WS_PE = 288 * MiB;
constexpr int LDS_BYTES = 147456;
#ifndef P5_NO_RMW
#define P5_NO_RMW 0
#endif
#ifndef N_LAUNCHES
#define N_LAUNCHES 1
#endif
#ifndef DIAG7_SEL
#define DIAG7_SEL 0
#endif
#ifndef SCAN_DIRECT_V
#define SCAN_DIRECT_V 2
#endif
#ifndef DIAG13_WHICH
#define DIAG13_WHICH 0
#endif
#ifndef DIAG14_ROW
#define DIAG14_ROW 37
#endif
#ifndef DIAG_HD
#define DIAG_HD 5
#endif
#ifndef DIAG_B
#define DIAG_B 1
#define DIAG_H 2
#endif
#ifndef DIAG_CLO
#define DIAG_CLO 0
#define DIAG_CHI 128
#endif
#ifndef SYS_INV
#define SYS_INV 0
#endif
#ifndef DIAG4_SGONLY
#define DIAG4_SGONLY 1
#endif
#ifndef DIAG
#define DIAG 0
#endif
#ifndef USE_CG_SYNC
#define USE_CG_SYNC 1
#endif
constexpr int ZC_QA = 0, ZC_KA = 512, ZC_VA = 1024, ZC_QB = 2048, ZC_KB = 3072, ZC_VB = 4096, ZC_OA = 3072, ZC_OB = 2048;

struct Params {
    const float* x; const float* p; const float* g_mix; const float* w_in; const float* w_alpha; const float* b_alpha;
    const float* g_gla; const float* w_out_gla; const float* w_out_sb; const float* w_out; const float* g_ple;
    const float* w_ple_gate; const float* w_ple; const float* g_final;
    float* out; unsigned char* ws;
    int ph_lo, ph_hi;
};

__device__ __forceinline__ unsigned cvt_pk(float lo, float hi) { unsigned r; asm volatile("v_cvt_pk_bf16_f32 %0, %1, %2" : "=v"(r) : "v"(lo), "v"(hi)); return r; }
__device__ __forceinline__ bf16_t f2bf(float f) { return (bf16_t)(cvt_pk(f, 0.f) & 0xffffu); }
__device__ __forceinline__ float bf2f(unsigned h) { return __uint_as_float(h << 16); }
__device__ __forceinline__ float bflo(unsigned w) { return __uint_as_float(w << 16); }
__device__ __forceinline__ float bfhi(unsigned w) { return __uint_as_float(w & 0xffff0000u); }
__device__ __forceinline__ float fexp2(float x) { return __builtin_amdgcn_exp2f(x); }
__device__ __forceinline__ float flog2(float x) { return __builtin_amdgcn_logf(x); }
__device__ __forceinline__ float fexp(float x) { return __builtin_amdgcn_exp2f(x * 1.4426950408889634f); }
__device__ __forceinline__ float frcp(float x) { return __builtin_amdgcn_rcpf(x); }
__device__ __forceinline__ float sigmoidf_(float a) { return frcp(1.0f + fexp(-a)); }
__device__ __forceinline__ float siluf_(float a) { return a * sigmoidf_(a); }
__device__ __forceinline__ float logsigmoidf_(float x) { return fminf(x, 0.f) - 0.6931471805599453f * flog2(1.0f + fexp(-fabsf(x))); }
__device__ __forceinline__ float wave_sum(float v) {
#pragma unroll
    for (int o = 1; o < 64; o <<= 1) v += __shfl_xor(v, o);
    return v;
}
__device__ __forceinline__ int fresh_tid() { int t = threadIdx.x; asm volatile("" : "+v"(t)); return t; }
#define LDS_WAIT() asm volatile("s_waitcnt lgkmcnt(0)" ::: "memory")
#define VM_WAIT() asm volatile("s_waitcnt vmcnt(0)" ::: "memory")

__device__ __forceinline__ void p0_item(const float* W, int ldw, int src0, int nv, const float* rs, bf16_t* WT, int K, int n0, int k0, LAS float* scr, int lane) {
    const int c = lane & 31;
#pragma unroll 8
    for (int i = 0; i < 32; ++i) {
        const int kk = 2 * i + (lane >> 5);
        float v = 0.f;
        if (c < nv) v = W[(size_t)(k0 + kk) * ldw + src0 + c];
        if (rs) v *= rs[k0 + kk];
        scr[kk * 33 + c] = v;
    }
    LDS_WAIT(); asm volatile("" ::: "memory");
    const int c8 = lane & 7;
#pragma unroll
    for (int j = 0; j < 4; ++j) {
        const int n = (lane >> 3) + 8 * j; const LAS float* s = scr + (8 * c8) * 33 + n;
        u32x4 o; o.x = cvt_pk(s[0 * 33], s[1 * 33]); o.y = cvt_pk(s[2 * 33], s[3 * 33]); o.z = cvt_pk(s[4 * 33], s[5 * 33]); o.w = cvt_pk(s[6 * 33], s[7 * 33]);
        *(u32x4*)(WT + (size_t)(n0 + n) * K + k0 + 8 * c8) = o;
    }
    LDS_WAIT(); asm volatile("" ::: "memory");
}

__device__ __forceinline__ void phase0(const Params& P, LAS unsigned char* lds, int tid, int G) {
    const int wave = tid >> 6, lane = tid & 63;
    const int gw = blockIdx.x * 8 + wave, NGW = G * 8;
    LAS float* scr = (LAS float*)(lds + wave * 16384);
    unsigned char* ws = P.ws;
    constexpr int I_W1 = 16 * 168, I_W4 = 16 * 128, I_SQ = 16 * 32, I_PE = 4 * 32;
    constexpr int NIT = I_W1 + I_W4 + 4 * I_SQ + I_PE;
    for (int it = gw; it < NIT; it += NGW) {
        int r = it;
        if (r < I_W1) {
            const int kb = r / 168, nb = r % 168, n0 = nb * 32; int src, nv;
            if (n0 < 2048) { src = n0; nv = 32; } else if (n0 < 5120) { src = n0 + 1040; nv = 32; } else if (n0 == 5120) { src = 2048; nv = 16; } else { src = 0; nv = 0; }
            p0_item(P.w_in, 9232, src, nv, nullptr, (bf16_t*)(ws + WS_W1T), 1024, n0, kb * 64, scr, lane); continue;
        }
        r -= I_W1;
        if (r < I_W4) {
            const int kb = r / 128, nb = r % 128, n0 = nb * 32; const int src = (n0 < 1024) ? 2064 + n0 : n0 + 5136;
            p0_item(P.w_in, 9232, src, 32, nullptr, (bf16_t*)(ws + WS_W4T), 1024, n0, kb * 64, scr, lane); continue;
        }
        r -= I_W4;
        if (r < 4 * I_SQ) {
            const int which = r / I_SQ; r -= which * I_SQ; const int kb = r / 32, nb = r % 32;
            const float* W = which == 0 ? P.w_out_gla : which == 1 ? P.w_out_sb : which == 2 ? P.w_out : P.w_ple_gate;
            bf16_t* dst = (bf16_t*)(ws + (which == 0 ? WS_WG : which == 1 ? WS_WS : which == 2 ? WS_WO : WS_WPG));
            p0_item(W, 1024, nb * 32, 32, which == 3 ? P.g_ple : nullptr, dst, 1024, nb * 32, kb * 64, scr, lane); continue;
        }
        r -= 4 * I_SQ;
        { const int kb = r / 32, nb = r % 32; p0_item(P.w_ple, 1024, nb * 32, 32, nullptr, (bf16_t*)(ws + WS_WPE), 256, nb * 32, kb * 64, scr, lane); }
    }
    bf16_t* H = (bf16_t*)(ws + WS_H);
    for (int m = gw; m < NTOK; m += NGW) {
        const f32x4* xr = (const f32x4*)(P.x + (size_t)m * DM) + lane; f32x4 v[4]; float s2 = 0.f;
#pragma unroll
        for (int j = 0; j < 4; ++j) { v[j] = xr[64 * j]; s2 += (v[j].x * v[j].x + v[j].y * v[j].y) + (v[j].z * v[j].z + v[j].w * v[j].w); }
        const float rstd = rsqrtf(wave_sum(s2) * (1.f / DM) + EPS);
        unsigned long long* o8 = (unsigned long long*)(H + (size_t)m * DM) + lane;
#pragma unroll
        for (int j = 0; j < 4; ++j) { const f32x4 g4 = ((const f32x4*)P.g_mix)[64 * j + lane]; const f32x4 o = v[j] * rstd * g4;
            o8[64 * j] = (unsigned long long)cvt_pk(o.x, o.y) | ((unsigned long long)cvt_pk(o.z, o.w) << 32); }
    }
    u32x4* PB = (u32x4*)(ws + WS_PB);
    for (int i = blockIdx.x * 512 + tid; i < NTOK * 256 / 8; i += G * 512) {
        const f32x4 a = ((const f32x4*)P.p)[2 * i], b = ((const f32x4*)P.p)[2 * i + 1];
        u32x4 o; o.x = cvt_pk(a.x, a.y); o.y = cvt_pk(a.z, a.w); o.z = cvt_pk(b.x, b.y); o.w = cvt_pk(b.z, b.w); PB[i] = o;
    }
}

typedef f32x4 AccT[2][2][4][2];
struct EpiZ1 {
    static constexpr bool PERM = true, AFTER_DRAIN = false;
    bf16_t* Z; float* LR;
    __device__ __forceinline__ void operator()(const AccT& acc, const pg8::Unit& u, int wr, int wc, int fr, int fq) const {
        const int row0 = u.pm * 256 + wr * 64 + fr;
        if (u.pn < 20) {
            const int col0 = u.pn * 256 + wc * 32 + 8 * fq;
#pragma unroll
            for (int ai = 0; ai < 2; ++ai)
#pragma unroll
                for (int m = 0; m < 4; ++m) { bf16_t* rowp = Z + (size_t)(row0 + ai * 128 + m * 16) * LDZ + col0;
#pragma unroll
                    for (int bj = 0; bj < 2; ++bj) { const f32x4 v0 = acc[ai][bj][m][0], v1 = acc[ai][bj][m][1];
                        u32x4 w; w.x = cvt_pk(v0[0], v0[1]); w.y = cvt_pk(v0[2], v0[3]); w.z = cvt_pk(v1[0], v1[1]); w.w = cvt_pk(v1[2], v1[3]);
                        *(u32x4*)(rowp + bj * 128) = w; } }
        } else if (wc == 0 && fq < 2) {
#pragma unroll
            for (int ai = 0; ai < 2; ++ai)
#pragma unroll
                for (int m = 0; m < 4; ++m) { float* lp = LR + (size_t)(row0 + ai * 128 + m * 16) * 16 + 8 * fq;
                    *(f32x4*)lp = acc[ai][0][m][0]; *(f32x4*)(lp + 4) = acc[ai][0][m][1]; }
        }
    }
};
struct EpiGates {
    static constexpr bool PERM = true, AFTER_DRAIN = false;
    bf16_t* Z; const float* SSA; const float* ggla; bf16_t* SG; bf16_t* SGX;
    __device__ __forceinline__ void operator()(const AccT& acc, const pg8::Unit& u, int wr, int wc, int fr, int fq) const {
        const int row0 = u.pm * 256 + wr * 64 + fr, cl = wc * 32 + 8 * fq;
        const int grp = u.pn >> 2;
        const int zc = (grp == 0 ? ZC_OA : grp == 1 ? ZC_OB : grp == 2 ? 0 : ZC_VB) + (u.pn & 3) * 256 + cl;
#pragma unroll
        for (int ai = 0; ai < 2; ++ai)
#pragma unroll
            for (int m = 0; m < 4; ++m) {
                const int r = row0 + ai * 128 + m * 16;
                float rstd = 1.f;
                if (grp == 0) { const f32x4* sp = (const f32x4*)(SSA + (size_t)r * 64 + u.pn * 16); const f32x4 a = sp[0], b = sp[1], c = sp[2], d = sp[3];
                    const float s = ((a.x + a.y) + (a.z + a.w)) + ((b.x + b.y) + (b.z + b.w)) + ((c.x + c.y) + (c.z + c.w)) + ((d.x + d.y) + (d.z + d.w));
                    rstd = rsqrtf(s * (1.f / 256.f) + EPS); }
                bf16_t* rowp = Z + (size_t)r * LDZ + zc;
#pragma unroll
                for (int bj = 0; bj < 2; ++bj) {
                    const f32x4 v0 = acc[ai][bj][m][0], v1 = acc[ai][bj][m][1];
                    float a[8] = {v0[0], v0[1], v0[2], v0[3], v1[0], v1[1], v1[2], v1[3]}; float o[8];
                    bf16_t* op = rowp + bj * 128;
                    if (grp < 2) {
                        const u32x4 ov = *(const u32x4*)op;
                        float ovf[8] = {bflo(ov.x), bfhi(ov.x), bflo(ov.y), bfhi(ov.y), bflo(ov.z), bfhi(ov.z), bflo(ov.w), bfhi(ov.w)};
#if DIAG == 1 || DIAG == 3 || DIAG == 4 || DIAG == 8 || DIAG == 5 || DIAG == 6
                        for (int e = 0; e < 8; ++e) ovf[e] = 1.0f;
                        rstd = 1.f;
#endif
                        if (grp == 0) { const int c = (u.pn & 3) * 256 + bj * 128 + cl; const f32x4 g0 = *(const f32x4*)(ggla + c), g1 = *(const f32x4*)(ggla + c + 4);
                            const float gg[8] = {g0.x, g0.y, g0.z, g0.w, g1.x, g1.y, g1.z, g1.w};
#pragma unroll
                            for (int e = 0; e < 8; ++e) o[e] = ovf[e] * rstd * gg[e] * siluf_(a[e]);
                        } else {
#pragma unroll
                            for (int e = 0; e < 8; ++e) o[e] = ovf[e] * siluf_(a[e]);
                        }
                    } else {
#pragma unroll
                        for (int e = 0; e < 8; ++e) o[e] = sigmoidf_(a[e]);
                    }
                    u32x4 w; w.x = cvt_pk(o[0], o[1]); w.y = cvt_pk(o[2], o[3]); w.z = cvt_pk(o[4], o[5]); w.w = cvt_pk(o[6], o[7]);
                    *(u32x4*)op = w;
                }
            }
    }
};
struct EpiMerge {
    static constexpr bool PERM = true, AFTER_DRAIN = false;
    bf16_t* MG; const bf16_t* SG;
    __device__ __forceinline__ void operator()(const AccT& acc, const pg8::Unit& u, int wr, int wc, int fr, int fq) const {
        const int row0 = u.pm * 256 + wr * 64 + fr, cl = u.pn * 256 + wc * 32 + 8 * fq;
#pragma unroll
        for (int ai = 0; ai < 2; ++ai)
#pragma unroll
            for (int m = 0; m < 4; ++m) {
                const int r = row0 + ai * 128 + m * 16;
#pragma unroll
                for (int bj = 0; bj < 2; ++bj) {
                    const int c = cl + bj * 128;
                    const f32x4 v0 = acc[ai][bj][m][0], v1 = acc[ai][bj][m][1];
                    const float a[8] = {v0[0], v0[1], v0[2], v0[3], v1[0], v1[1], v1[2], v1[3]};
                    const u32x4 sv = *(const u32x4*)(SG + (size_t)r * LDZ + (u.sel ? ZC_VB : 0) + c);
                    const float sg[8] = {bflo(sv.x), bfhi(sv.x), bflo(sv.y), bfhi(sv.y), bflo(sv.z), bfhi(sv.z), bflo(sv.w), bfhi(sv.w)};
                    float o[8];
                    bf16_t* mp = MG + (size_t)r * LDZ + c;
#if P5_NO_RMW
                    if (u.sel) continue;
#endif
                    if (u.sel) { const u32x4 tv = *(const u32x4*)mp;
                        const float tt[8] = {bflo(tv.x), bfhi(tv.x), bflo(tv.y), bfhi(tv.y), bflo(tv.z), bfhi(tv.z), bflo(tv.w), bfhi(tv.w)};
#pragma unroll
                        for (int e = 0; e < 8; ++e) o[e] = tt[e] + sg[e] * a[e];
                    } else {
#pragma unroll
                        for (int e = 0; e < 8; ++e) o[e] = sg[e] * a[e];
                    }
                    u32x4 w; w.x = cvt_pk(o[0], o[1]); w.y = cvt_pk(o[2], o[3]); w.z = cvt_pk(o[4], o[5]); w.w = cvt_pk(o[6], o[7]);
                    *(u32x4*)mp = w;
                }
            }
    }
};
struct EpiX1 {
    static constexpr bool PERM = false, AFTER_DRAIN = false;
    const float* X; bf16_t* ZR; float* SS;
    __device__ __forceinline__ void operator()(const AccT& acc, const pg8::Unit& u, int wr, int wc, int fr, int fq) const {
        const int row0 = u.pm * 256 + wr * 64 + fr, cl = u.pn * 256 + wc * 32 + 4 * fq;
#pragma unroll
        for (int ai = 0; ai < 2; ++ai)
#pragma unroll
            for (int m = 0; m < 4; ++m) {
                const int r = row0 + ai * 128 + m * 16; float ss = 0.f;
#pragma unroll
                for (int bj = 0; bj < 2; ++bj)
#pragma unroll
                    for (int n = 0; n < 2; ++n) {
                        const int c = cl + bj * 128 + n * 16; const size_t off = (size_t)r * 1024 + c;
                        const f32x4 v = *(const f32x4*)(X + off) + acc[ai][bj][m][n];
                        *(f32x4*)((float*)(ZR + (size_t)r * LDZ + 2048) + c) = v;
                        u32x2 w; w.x = cvt_pk(v.x, v.y); w.y = cvt_pk(v.z, v.w); *(u32x2*)(ZR + (size_t)r * LDZ + c) = w;
                        ss += (v.x * v.x + v.y * v.y) + (v.z * v.z + v.w * v.w);
                    }
                ss += __shfl_xor(ss, 16); ss += __shfl_xor(ss, 32);
                if (fq == 0) SS[(size_t)r * 16 + u.pn * 4 + wc] = ss;
            }
    }
};
struct EpiPE {
    static constexpr bool PERM = false, AFTER_DRAIN = false;
    bf16_t* PE;
    __device__ __forceinline__ void operator()(const AccT& acc, const pg8::Unit& u, int wr, int wc, int fr, int fq) const {
        const int row0 = u.pm * 256 + wr * 64 + fr, cl = u.pn * 256 + wc * 32 + 4 * fq;
#pragma unroll
        for (int ai = 0; ai < 2; ++ai)
#pragma unroll
            for (int m = 0; m < 4; ++m) {
                const int r = row0 + ai * 128 + m * 16;
#pragma unroll
                for (int bj = 0; bj < 2; ++bj)
#pragma unroll
                    for (int n = 0; n < 2; ++n) { const f32x4 v = acc[ai][bj][m][n]; u32x2 w; w.x = cvt_pk(v.x, v.y); w.y = cvt_pk(v.z, v.w);
                        *(u32x2*)(PE + (size_t)r * LDZ + ZC_VB + cl + bj * 128 + n * 16) = w; }
            }
    }
};
struct EpiX2 {
    static constexpr bool PERM = false, AFTER_DRAIN = false;
    bf16_t* ZR; const float* SS1; float* SS2;
    __device__ __forceinline__ void operator()(const AccT& acc, const pg8::Unit& u, int wr, int wc, int fr, int fq) const {
        const int row0 = u.pm * 256 + wr * 64 + fr, cl = u.pn * 256 + wc * 32 + 4 * fq;
#pragma unroll
        for (int ai = 0; ai < 2; ++ai)
#pragma unroll
            for (int m = 0; m < 4; ++m) {
                const int r = row0 + ai * 128 + m * 16;
                const f32x4* sp = (const f32x4*)(SS1 + (size_t)r * 16); const f32x4 a = sp[0], b = sp[1], c4 = sp[2], d = sp[3];
                const float s = ((a.x + a.y) + (a.z + a.w)) + ((b.x + b.y) + (b.z + b.w)) + ((c4.x + c4.y) + (c4.z + c4.w)) + ((d.x + d.y) + (d.z + d.w));
                const float rstd = rsqrtf(s * (1.f / 1024.f) + EPS);
                float ss = 0.f;
#pragma unroll
                for (int bj = 0; bj < 2; ++bj)
#pragma unroll
                    for (int n = 0; n < 2; ++n) {
                        const int c = cl + bj * 128 + n * 16;
                        float* xp = (float*)(ZR + (size_t)r * LDZ + 2048) + c;
                        const f32x4 x1 = *(const f32x4*)xp; const u32x2 pw = *(const u32x2*)(ZR + (size_t)r * LDZ + ZC_VB + c);
                        const f32x4 g = acc[ai][bj][m][n] * rstd;
                        f32x4 v;
                        v.x = x1.x + sigmoidf_(g.x) * bflo(pw.x); v.y = x1.y + sigmoidf_(g.y) * bfhi(pw.x);
                        v.z = x1.z + sigmoidf_(g.z) * bflo(pw.y); v.w = x1.w + sigmoidf_(g.w) * bfhi(pw.y);
                        *(f32x4*)xp = v;
                        ss += (v.x * v.x + v.y * v.y) + (v.z * v.z + v.w * v.w);
                    }
                ss += __shfl_xor(ss, 16); ss += __shfl_xor(ss, 32);
                if (fq == 0) SS2[(size_t)r * 16 + u.pn * 4 + wc] = ss;
            }
    }
};
struct PairOrder {
    pg8::StaticOrder base;
    __device__ void init(int M, int N, int G, int c) { base.init(M, N, G, c); }
    __device__ bool next(int i, pg8::Unit& u) const { if (!base.next(i >> 1, u)) return false; u.sel = i & 1; return true; }
    __device__ __forceinline__ void a_ready(const pg8::Unit&) const {}
    __device__ __forceinline__ void done(const pg8::Unit&) const {}
};

__device__ __forceinline__ int qperm(int dl) { return 8 * ((dl & 15) >> 2) + (dl & 3) + 4 * (dl >> 4); }
__device__ __forceinline__ void gla_prep_unit(const Params& P, LAS unsigned char* lds, int id, int tid) {
    const int b = id >> 9, c = (id >> 2) & 127, h = id & 3;
    const size_t tok0 = (size_t)b * SEQ + (size_t)c * 64;
    bf16_t* Z = (bf16_t*)(P.ws + WS_Z1);
    const float* LR = (const float*)(P.ws + WS_LR);
    float* DEC = (float*)(P.ws + WS_DEC);
    bf16_t* ATT = (bf16_t*)(P.ws + WS_ATTN);
    LAS bf16_t* QD = (LAS bf16_t*)lds; LAS bf16_t* KD = QD + 64 * 136; LAS bf16_t* QI = KD + 64 * 136; LAS bf16_t* KI = QI + 64 * 136;
    LAS float* lrs = (LAS float*)(lds + 4 * 64 * 136 * 2);
    LAS float* gs = lrs + 1024;
    const int d = tid & 127, tq = tid >> 7;
    if (tid < 256) ((LAS f32x4*)lrs)[tid] = ((const f32x4*)(LR + tok0 * 16))[tid];
    float wa[16];
#pragma unroll
    for (int r = 0; r < 16; ++r) wa[r] = P.w_alpha[r * 512 + h * 128 + d];
    const float ba = P.b_alpha[h * 128 + d];
    float qv[16], kv[16];
#pragma unroll
    for (int i = 0; i < 16; ++i) { const size_t row = tok0 + tq * 16 + i;
        qv[i] = bf2f(Z[row * LDZ + ZC_QA + h * 128 + d]); kv[i] = bf2f(Z[row * LDZ + ZC_KA + h * 128 + d]); }
    __syncthreads();
    float bc[16]; float run = 0.f;
#pragma unroll
    for (int i = 0; i < 16; ++i) { const int t = tq * 16 + i; float pre = ba;
#pragma unroll
        for (int r = 0; r < 16; ++r) pre += lrs[t * 16 + r] * wa[r];
        run += logsigmoidf_(pre) * (1.f / 16.f); bc[i] = run; }
    gs[tq * 128 + d] = run;
    VM_WAIT();
    __syncthreads();
    float off = 0.f, blast = 0.f;
#pragma unroll
    for (int g = 0; g < 4; ++g) { const float v = gs[g * 128 + d]; if (g < tq) off += v; blast += v; }
    const float scale = 0.08838834764831845f;
    float ke[16];
    const int dperm = (d & ~31) + qperm(d & 31);
#pragma unroll
    for (int i = 0; i < 16; ++i) {
        const float bb = bc[i] + off; const float eb = fexp(bb), enb = fexp(-bb);
        const int t = tq * 16 + i;
        const float qs = qv[i] * scale;
        const bf16_t qd = f2bf(qs * eb);
        QD[t * 136 + d] = qd; QI[t * 136 + d] = f2bf(qs * enb); KD[t * 136 + d] = f2bf(kv[i] * enb); KI[t * 136 + d] = f2bf(kv[i] * eb);
        Z[(tok0 + t) * LDZ + ZC_QA + h * 128 + dperm] = qd;
        ke[i] = kv[i] * fexp(blast - bb);
    }
    { u32x4 w0, w1; w0.x = cvt_pk(ke[0], ke[1]); w0.y = cvt_pk(ke[2], ke[3]); w0.z = cvt_pk(ke[4], ke[5]); w0.w = cvt_pk(ke[6], ke[7]);
      w1.x = cvt_pk(ke[8], ke[9]); w1.y = cvt_pk(ke[10], ke[11]); w1.z = cvt_pk(ke[12], ke[13]); w1.w = cvt_pk(ke[14], ke[15]);
      bf16_t* kp = Z + (tok0 + (d >> 1)) * LDZ + ZC_KA + h * 128 + (d & 1) * 64 + tq * 16;
      *(u32x4*)kp = w0; *(u32x4*)(kp + 8) = w1; }
    if (tq == 0) DEC[(size_t)id * 128 + d] = fexp(blast);
    __syncthreads();
    const int wave = tid >> 6, lane = tid & 63, fr = lane & 15, fq = lane >> 4;
#pragma unroll
    for (int tt = 0; tt < 2; ++tt) {
        const int tile = 2 * wave + tt, si = tile >> 2, ti = tile & 3;
        f32x4 ap = {0.f, 0.f, 0.f, 0.f}, af = {0.f, 0.f, 0.f, 0.f};
#pragma unroll
        for (int kk = 0; kk < 4; ++kk) {
            const bf16x8 a1 = *(const LAS bf16x8*)(KD + (16 * si + fr) * 136 + 32 * kk + 8 * fq), b1 = *(const LAS bf16x8*)(QD + (16 * ti + fr) * 136 + 32 * kk + 8 * fq);
            const bf16x8 a2 = *(const LAS bf16x8*)(KI + (16 * si + fr) * 136 + 32 * kk + 8 * fq), b2 = *(const LAS bf16x8*)(QI + (16 * ti + fr) * 136 + 32 * kk + 8 * fq);
            ap = __builtin_amdgcn_mfma_f32_16x16x32_bf16(a1, b1, ap, 0, 0, 0);
            af = __builtin_amdgcn_mfma_f32_16x16x32_bf16(a2, b2, af, 0, 0, 0);
        }
        const int sb = 16 * si + 4 * fq, t = 16 * ti + fr;
        float v[4];
#pragma unroll
        for (int j = 0; j < 4; ++j) v[j] = (sb + j <= t) ? ap[j] : af[j];
        u32x2 w; w.x = cvt_pk(v[0], v[1]); w.y = cvt_pk(v[2], v[3]);
        *(u32x2*)(ATT + (size_t)id * 4096 + t * 64 + sb) = w;
    }
    __syncthreads();
}

__device__ __forceinline__ s16x4 lds_tr(LAS unsigned char* p) { return __builtin_bit_cast(s16x4, __builtin_amdgcn_ds_read_tr16_b64_v4i16((LAS s16x4*)p)); }
__device__ __forceinline__ bf16x8 cat8(s16x4 lo, s16x4 hi) { bf16x8 r; r[0] = lo[0]; r[1] = lo[1]; r[2] = lo[2]; r[3] = lo[3]; r[4] = hi[0]; r[5] = hi[1]; r[6] = hi[2]; r[7] = hi[3]; return r; }
__device__ __forceinline__ void sb_unit(const Params& P, LAS unsigned char* lds, int id, int tid) {
    const int b = id >> 8, hd = (id >> 5) & 7, qt = id & 31;
    const int wave = tid >> 6, lane = tid & 63, ql = lane & 31, hh = lane >> 5;
    const int q0 = qt * 256, qw = q0 + 32 * wave, t = qw + ql;
    LAS unsigned char* Ks = lds; LAS unsigned char* Vs = lds + 64 * 272; LAS int* flags = (LAS int*)(lds + 2 * 64 * 272);
    bf16_t* Zb = (bf16_t*)(P.ws + WS_Z1) + (size_t)b * SEQ * LDZ;
    bf16x8 qf[8];
#pragma unroll
    for (int kk = 0; kk < 8; ++kk) qf[kk] = *(const bf16x8*)(Zb + (size_t)t * LDZ + ZC_QB + hd * 128 + 16 * kk + 8 * hh);
    f32x16 oacc[4];
#pragma unroll
    for (int db = 0; db < 4; ++db)
#pragma unroll
        for (int i = 0; i < 16; ++i) oacc[db][i] = 0.f;
    float R = 0.f; int wdone = 0;
    __syncthreads();
    if (lane == 0) flags[wave] = 0;
    const int i16 = lane & 15, blk = (lane >> 4) & 1;
    const float c2 = 0.08838834764831845f * 1.4426950408889634f;
    for (int kt = 4 * qt + 3; kt >= 0; --kt) {
        __syncthreads();
        int alld = 1;
#pragma unroll
        for (int w = 0; w < 8; ++w) alld &= flags[w];
        if (alld) break;
        const int key0 = 64 * kt;
#pragma unroll
        for (int i = 0; i < 2; ++i) { const int ch = tid + 512 * i, row = ch >> 4, cc = ch & 15;
            const bf16_t* src = Zb + (size_t)(key0 + row) * LDZ + hd * 128 + cc * 8;
            const u32x4 kvv = *(const u32x4*)(src + ZC_KB), vvv = *(const u32x4*)(src + ZC_VB);
            *(LAS u32x4*)(Ks + row * 272 + cc * 16) = kvv; *(LAS u32x4*)(Vs + row * 272 + cc * 16) = vvv; }
        __syncthreads();
        if (!wdone && key0 <= qw + 30) {
#pragma unroll
            for (int kb = 1; kb >= 0; --kb) {
                const int kbase = key0 + 32 * kb;
                if (kbase > qw + 30) continue;
                f32x16 sacc;
#pragma unroll
                for (int i = 0; i < 16; ++i) sacc[i] = 0.f;
#pragma unroll
                for (int kk = 0; kk < 8; ++kk) { const bf16x8 a = *(const LAS bf16x8*)(Ks + (32 * kb + ql) * 272 + (16 * kk + 8 * hh) * 2);
                    sacc = __builtin_amdgcn_mfma_f32_32x32x16_bf16(a, qf[kk], sacc, 0, 0, 0); }
                float L[16], zl[16];
#pragma unroll
                for (int i = 0; i < 16; ++i) { const int key = kbase + 8 * (i >> 2) + 4 * hh + (i & 3); const bool valid = key < t;
                    const float z2 = sacc[i] * c2; const float sp = fmaxf(z2, 0.f) + flog2(1.0f + fexp2(-fabsf(z2)));
                    const float l = valid ? -sp : 0.f; L[i] = l; zl[i] = valid ? (z2 + l) : -1.0e30f; }
                float Pg[4], Qg[4], Tg[4];
#pragma unroll
                for (int g = 0; g < 4; ++g) { Pg[g] = (L[4 * g] + L[4 * g + 1]) + (L[4 * g + 2] + L[4 * g + 3]); Qg[g] = __shfl_xor(Pg[g], 32); }
                Tg[3] = 0.f; Tg[2] = Pg[3] + Qg[3]; Tg[1] = Tg[2] + (Pg[2] + Qg[2]); Tg[0] = Tg[1] + (Pg[1] + Qg[1]);
                const float total = Tg[0] + (Pg[0] + Qg[0]);
                float w[16];
#pragma unroll
                for (int g = 0; g < 4; ++g) { float e = R + Tg[g] + (hh == 0 ? Qg[g] : 0.f);
                    w[4 * g + 3] = fexp2(zl[4 * g + 3] + e); e += L[4 * g + 3];
                    w[4 * g + 2] = fexp2(zl[4 * g + 2] + e); e += L[4 * g + 2];
                    w[4 * g + 1] = fexp2(zl[4 * g + 1] + e); e += L[4 * g + 1];
                    w[4 * g + 0] = fexp2(zl[4 * g + 0] + e); }
                R += total;
                bf16x8 pa[2];
#pragma unroll
                for (int gp = 0; gp < 2; ++gp) { u32x4 pw; pw.x = cvt_pk(w[8 * gp], w[8 * gp + 1]); pw.y = cvt_pk(w[8 * gp + 2], w[8 * gp + 3]); pw.z = cvt_pk(w[8 * gp + 4], w[8 * gp + 5]); pw.w = cvt_pk(w[8 * gp + 6], w[8 * gp + 7]);
                    pa[gp] = __builtin_bit_cast(bf16x8, pw); }
#pragma unroll
                for (int gp = 0; gp < 2; ++gp)
#pragma unroll
                    for (int db = 0; db < 4; ++db) {
                        LAS unsigned char* vp = Vs + (32 * kb + 16 * gp + 4 * hh + (i16 >> 2)) * 272 + (32 * db + 16 * blk + 4 * (i16 & 3)) * 2;
                        const s16x4 lo = lds_tr(vp), hi = lds_tr(vp + 8 * 272);
                        oacc[db] = __builtin_amdgcn_mfma_f32_32x32x16_bf16(pa[gp], cat8(lo, hi), oacc[db], 0, 0, 0);
                    }
            }
            wdone = __all(R < -151.0f) ? 1 : 0;
        }
        if (lane == 0) flags[wave] = wdone;
    }
#pragma unroll
    for (int db = 0; db < 4; ++db)
#pragma unroll
        for (int i = 0; i < 16; ++i) { const int qr = qw + (i & 3) + 8 * (i >> 2) + 4 * hh;
            Zb[(size_t)qr * LDZ + ZC_OB + hd * 128 + 32 * db + ql] = f2bf(oacc[db][i]); }
}

__device__ __forceinline__ void gla_scan_unit(const Params& P, LAS unsigned char* lds, int unit, int wave, int lane) {
    const int b = unit >> 6, h = (unit >> 4) & 3, sl = unit & 15;
    const int fr = lane & 15, fq = lane >> 4, tw = wave;
    LAS unsigned char* vl = lds + wave * 2048;
    bf16_t* Zb = (bf16_t*)(P.ws + WS_Z1) + (size_t)b * SEQ * LDZ;
    const float* DEC = (const float*)(P.ws + WS_DEC);
    const bf16_t* ATT = (const bf16_t*)(P.ws + WS_ATTN);
    float* SSA = (float*)(P.ws + WS_SSA);
    f32x4 S[8];
#pragma unroll
    for (int mt = 0; mt < 8; ++mt) S[mt] = (f32x4){0.f, 0.f, 0.f, 0.f};
    u32x4 vr0, vr1; bf16x8 aa[2], qa[4], ka[8][2];
#define SCAN_LOAD(cc) do { const int tk = (cc) * 64; const size_t idn = ((size_t)b * 128 + (cc)) * 4 + h; \
        const u32x4* vp_ = (const u32x4*)(Zb + (size_t)(tk + lane) * LDZ + ZC_VA + h * 256 + sl * 16); vr0 = vp_[0]; vr1 = vp_[1]; \
        _Pragma("unroll") for (int ks = 0; ks < 2; ++ks) aa[ks] = *(const bf16x8*)(ATT + idn * 4096 + (16 * tw + fr) * 64 + 32 * ks + 8 * fq); \
        _Pragma("unroll") for (int kq = 0; kq < 4; ++kq) qa[kq] = *(const bf16x8*)(Zb + (size_t)(tk + 16 * tw + fr) * LDZ + ZC_QA + h * 128 + 32 * kq + 8 * fq); \
        _Pragma("unroll") for (int mt = 0; mt < 8; ++mt) _Pragma("unroll") for (int ks = 0; ks < 2; ++ks) { const int dk = 16 * mt + fr; \
            ka[mt][ks] = *(const bf16x8*)(Zb + (size_t)(tk + (dk >> 1)) * LDZ + ZC_KA + h * 128 + (dk & 1) * 64 + 32 * ks + 8 * fq); } } while (0)
    SCAN_LOAD(0);
    for (int c = 0; c < 128; ++c) {
        const size_t id = ((size_t)b * 128 + c) * 4 + h;
#if SCAN_DIRECT_V == 1
        bf16x8 bv[2];
#pragma unroll
        for (int ks = 0; ks < 2; ++ks)
#pragma unroll
            for (int j = 0; j < 8; ++j) bv[ks][j] = (short)Zb[(size_t)(c * 64 + 32 * ks + 8 * fq + j) * LDZ + ZC_VA + h * 256 + sl * 16 + fr];
#else
        *(LAS u32x4*)(vl + lane * 32) = vr0; *(LAS u32x4*)(vl + lane * 32 + 16) = vr1;
        asm volatile("s_waitcnt lgkmcnt(0)" ::: "memory");
        bf16x8 bv[2];
#pragma unroll
#if SCAN_DIRECT_V == 2
        for (int ks = 0; ks < 2; ++ks)
#pragma unroll
            for (int j = 0; j < 8; ++j) bv[ks][j] = *(const LAS short*)(vl + (32 * ks + 8 * fq + j) * 32 + fr * 2);
#else
        for (int ks = 0; ks < 2; ++ks) { LAS unsigned char* vp = vl + (32 * ks + 8 * fq + (fr >> 2)) * 32 + (fr & 3) * 8;
            const s16x4 lo = lds_tr(vp), hi = lds_tr(vp + 4 * 32); bv[ks] = cat8(lo, hi); }
#endif
        asm volatile("s_waitcnt lgkmcnt(0)" ::: "memory");
#endif
        f32x4 o = {0.f, 0.f, 0.f, 0.f};
        o = __builtin_amdgcn_mfma_f32_16x16x32_bf16(aa[0], bv[0], o, 0, 0, 0);
        o = __builtin_amdgcn_mfma_f32_16x16x32_bf16(aa[1], bv[1], o, 0, 0, 0);
#pragma unroll
        for (int kq = 0; kq < 4; ++kq) { u32x4 sw; sw.x = cvt_pk(S[2 * kq][0], S[2 * kq][1]); sw.y = cvt_pk(S[2 * kq][2], S[2 * kq][3]); sw.z = cvt_pk(S[2 * kq + 1][0], S[2 * kq + 1][1]); sw.w = cvt_pk(S[2 * kq + 1][2], S[2 * kq + 1][3]);
            o = __builtin_amdgcn_mfma_f32_16x16x32_bf16(qa[kq], __builtin_bit_cast(bf16x8, sw), o, 0, 0, 0); }
#pragma unroll
        for (int mt = 0; mt < 8; ++mt) { const f32x4 dc = *(const f32x4*)(DEC + id * 128 + 16 * mt + 4 * fq);
            S[mt] = S[mt] * dc;
            S[mt] = __builtin_amdgcn_mfma_f32_16x16x32_bf16(ka[mt][0], bv[0], S[mt], 0, 0, 0);
            S[mt] = __builtin_amdgcn_mfma_f32_16x16x32_bf16(ka[mt][1], bv[1], S[mt], 0, 0, 0); }
        const int cn = (c + 1) & 127;
        SCAN_LOAD(cn);
#pragma unroll
        for (int j = 0; j < 4; ++j) {
            const size_t tok = (size_t)c * 64 + 16 * tw + 4 * fq + j;
            Zb[tok * LDZ + ZC_OA + h * 256 + sl * 16 + fr] = f2bf(o[j]);
            float q = o[j] * o[j];
            q += __shfl_xor(q, 1); q += __shfl_xor(q, 2); q += __shfl_xor(q, 4); q += __shfl_xor(q, 8);
            if (fr == 0) SSA[((size_t)b * SEQ + tok) * 64 + h * 16 + sl] = q;
        }
    }
#undef SCAN_LOAD
}

__global__ void __launch_bounds__(512, 2) fwd_kernel(Params P) {
    extern __shared__ __attribute__((aligned(16))) unsigned char lds_raw[];
#if N_LAUNCHES == 1
    cg::grid_group grid = cg::this_grid();
#endif
    LAS unsigned char* lds = (LAS unsigned char*)lds_raw;
    volatile LAS unsigned* MISC = (volatile LAS unsigned*)(lds + 131072 + 320);
    if (threadIdx.x < 32) MISC[threadIdx.x] = 0u;
    __syncthreads();
#if !USE_CG_SYNC
    XcdBarrier bar = xcd_barrier_post((unsigned*)P.ws + 4096, MISC + 8);
#endif
#if N_LAUNCHES != 1
#define GRID_SYNC() do { } while (0)
#elif USE_CG_SYNC
#define GRID_SYNC() do { asm volatile("s_waitcnt vmcnt(0)" ::: "memory"); grid.sync(); __builtin_amdgcn_fence(__ATOMIC_ACQUIRE, "agent"); asm volatile("s_waitcnt vmcnt(0)" ::: "memory"); } while (0)
#else
#if SYS_INV
#define GRID_SYNC() do { asm volatile("s_waitcnt vmcnt(0)\n\tbuffer_wbl2 sc0 sc1\n\ts_waitcnt vmcnt(0)" ::: "memory"); xcd_barrier(bar); asm volatile("buffer_inv sc0 sc1\n\ts_waitcnt vmcnt(0)" ::: "memory"); __syncthreads(); } while (0)
#else
#define GRID_SYNC() xcd_barrier(bar)
#endif
#endif
    const int G = gridDim.x;
    unsigned char* ws = P.ws;
    bf16_t* Z = (bf16_t*)(ws + WS_Z1);
    bf16_t* H = (bf16_t*)(ws + WS_H);

#if N_LAUNCHES == 1
#define IN(k) true
#else
#define IN(k) (P.ph_lo <= (k) && (k) < P.ph_hi)
#endif
#define BOTH(k) (IN(k) && IN((k) + 1))
    if (IN(0)) {
#if DIAG == 4
    { const int tid = fresh_tid(); for (size_t i = (size_t)blockIdx.x * 512 + tid; i < (size_t)NTOK * 1024; i += (size_t)G * 512) P.out[i] = 0.f; }
#endif
    phase0(P, lds, fresh_tid(), G);
    }
    if (BOTH(0)) GRID_SYNC();
    if (IN(1)) {
#if DIAG == 9
    { const int tid = fresh_tid(); const bf16_t* w0 = (const bf16_t*)(ws + WS_WG); const bf16_t* w1 = (const bf16_t*)(ws + WS_WS); const bf16_t* w2 = (const bf16_t*)(ws + WS_WO); const bf16_t* w3 = (const bf16_t*)(ws + WS_WPG); const bf16_t* w4 = (const bf16_t*)(ws + WS_WPE);
      const bf16_t* pb = (const bf16_t*)(ws + WS_PB);
      for (size_t i = (size_t)blockIdx.x * 512 + tid; i < (size_t)NTOK * 1024; i += (size_t)G * 512) { const size_t j = i & 0xFFFFF;
          P.out[i] = bf2f(((const bf16_t*)(ws + WS_W4T))[i & 0x3FFFFF]) + 2.f * bf2f(((const bf16_t*)(ws + WS_W1T))[i % (5376u * 1024u)]) + 3.f * bf2f(H[i]); }
      return; }
#endif
    {
        pg8::Gemm g{H, (const bf16_t*)(ws + WS_W1T), H, (const bf16_t*)(ws + WS_W1T), NTOK, 5376, 1024, 1024};
        pg8::StaticOrder S; S.init(NTOK, 5376, G, (int)blockIdx.x);
        EpiZ1 E{Z, (float*)(ws + WS_LR)};
        pg8::gemm_phase<EpiZ1, pg8::StaticOrder, true, true>(lds, g, S, E);
    }
    }
    if (BOTH(1)) GRID_SYNC();
    if (IN(2)) {
#if DIAG == 2
    {
        const int tid = fresh_tid();
        for (size_t i = (size_t)blockIdx.x * 512 + tid; i < (size_t)NTOK * 1024; i += (size_t)G * 512) { const size_t r = i >> 10, c = i & 1023;
            P.out[i] = bf2f(Z[r * LDZ + c + 2048]) + ((const float*)(ws + WS_LR))[r * 16 + (c & 15)]; }
        return;
    }
#endif
#if DIAG == 14
    {
        const int tid = fresh_tid(); const size_t r0 = (size_t)blockIdx.x * 128 + (tid & 127); const int grp = tid >> 7;
        if (blockIdx.x == 0 && tid == 0) { *(unsigned*)(ws + 500 * MiB) = 0u; *((unsigned*)(ws + 500 * MiB) + 64) = 0u; }
        float ss = 0.f; for (int k = 0; k < 1024; ++k) { const float v = P.x[r0 * 1024 + k]; ss += v * v; }
        const float rstd = rsqrtf(ss / 1024.f + EPS);
        const int cols[12] = {7, 300, 777, 1500, 2100, 3000, 3500, 4100, 5000, 5121, 1023, 4607};
        int bad = 0;
#pragma unroll
        for (int j = 0; j < 3; ++j) { const int n = cols[grp * 3 + j]; const int col = n < 2048 ? n : (n < 5120 ? n + 1040 : 2048 + (n - 5120)); float s = 0.f;
            for (int k = 0; k < 1024; ++k) s += P.x[r0 * 1024 + k] * rstd * P.g_mix[k] * P.w_in[(size_t)k * 9232 + col];
            const float g = n < 5120 ? bf2f(Z[r0 * LDZ + n]) : ((const float*)(ws + WS_LR))[r0 * 16 + (n - 5120)];
            if (fabsf(s - g) > 0.05f) ++bad; }
        if (bad) { atomicAdd((unsigned*)(ws + 500 * MiB), (unsigned)bad); atomicMax((unsigned*)(ws + 500 * MiB) + 64, (unsigned)(r0 & 255) + 1u); }
        __threadfence(); __syncthreads();
    }
    GRID_SYNC();
    { const int tid = fresh_tid(); const float cst = (float)__hip_atomic_load((const unsigned*)(ws + 500 * MiB) + DIAG13_WHICH * 64, __ATOMIC_RELAXED, __HIP_MEMORY_SCOPE_AGENT);
      for (size_t i = (size_t)blockIdx.x * 512 + tid; i < (size_t)NTOK * 1024; i += (size_t)G * 512) P.out[i] = cst; }
    return;
#endif
#if DIAG == 15
    if (blockIdx.x == 0) {
        const int tid = fresh_tid(); const int bq = DIAG_B, hq = DIAG_H;
        float* EXP = (float*)(ws + 470 * MiB); float* ST = (float*)(ws + 480 * MiB); float* BB = ST + 128 * 256; float* AT = BB + 64 * 128;
        const float* LRp = (const float*)(ws + WS_LR); const float sc = 0.08838834764831845f;
        if (tid == 0) { *(unsigned*)(ws + 500 * MiB) = 0u; *((unsigned*)(ws + 500 * MiB) + 64) = 0u; }
        for (int i = tid; i < 128 * 256; i += 512) ST[i] = 0.f;
        __threadfence(); __syncthreads();
        for (int c = 0; c < 128; ++c) {
            const size_t tk = (size_t)bq * SEQ + (size_t)c * 64;
            if (tid < 128) { const int d = tid; float run = 0.f;
                for (int t = 0; t < 64; ++t) { float pre = P.b_alpha[hq * 128 + d]; for (int r = 0; r < 16; ++r) pre += LRp[(tk + t) * 16 + r] * P.w_alpha[r * 512 + hq * 128 + d];
                    run += (fminf(pre, 0.f) - log1pf(expf(-fabsf(pre)))) / 16.f; BB[t * 128 + d] = run; } }
            __threadfence(); __syncthreads();
            for (int i = tid; i < 64 * 64; i += 512) { const int t = i >> 6, s = i & 63; float a = 0.f;
                for (int d = 0; d < 128; ++d) a += bf2f(Z[(tk + t) * LDZ + ZC_QA + hq * 128 + d]) * sc * bf2f(Z[(tk + s) * LDZ + ZC_KA + hq * 128 + d]) * expf(-fabsf(BB[t * 128 + d] - BB[s * 128 + d]));
                AT[i] = a; }
            __threadfence(); __syncthreads();
            for (int i = tid; i < 64 * 256; i += 512) { const int t = i >> 8, dv = i & 255; float o = 0.f;
                for (int s = 0; s < 64; ++s) o += AT[t * 64 + s] * bf2f(Z[(tk + s) * LDZ + ZC_VA + hq * 256 + dv]);
                for (int d = 0; d < 128; ++d) o += bf2f(Z[(tk + t) * LDZ + ZC_QA + hq * 128 + d]) * sc * expf(BB[t * 128 + d]) * ST[d * 256 + dv];
                EXP[((size_t)c * 64 + t) * 256 + dv] = o; }
            __threadfence(); __syncthreads();
            for (int i = tid; i < 128 * 256; i += 512) { const int d = i >> 8, dv = i & 255; float s_ = ST[i] * expf(BB[63 * 128 + d]);
                for (int s = 0; s < 64; ++s) s_ += bf2f(Z[(tk + s) * LDZ + ZC_KA + hq * 128 + d]) * expf(BB[63 * 128 + d] - BB[s * 128 + d]) * bf2f(Z[(tk + s) * LDZ + ZC_VA + hq * 256 + dv]);
                ST[i] = s_; }
            __threadfence(); __syncthreads();
        }
    }
    GRID_SYNC();
#endif
#if DIAG == 12
    {
        const int tid = fresh_tid(); float* EXP = (float*)(ws + 470 * MiB); const size_t t = (size_t)blockIdx.x * 128 + (tid & 127); const int d0 = (tid >> 7) * 32; const int hd = DIAG_HD;
        if (blockIdx.x == 0 && tid == 0) { *(unsigned*)(ws + 500 * MiB) = 0u; *((unsigned*)(ws + 500 * MiB) + 64) = 0u; }
        const long sb0 = (long)(t / SEQ) * SEQ;
        float o[32]; for (int e = 0; e < 32; ++e) o[e] = 0.f; float after = 0.f;
        for (long s = (long)t - 1; s >= sb0; --s) { float z = 0.f; for (int d = 0; d < 128; ++d) z += bf2f(Z[t * LDZ + ZC_QB + hd * 128 + d]) * bf2f(Z[(size_t)s * LDZ + ZC_KB + hd * 128 + d]);
            z *= 0.08838834764831845f;
            const float sp = log1pf(expf(-fabsf(z))); const float lsig = fminf(z, 0.f) - sp, l1m = fminf(-z, 0.f) - sp;
            const float w = expf(lsig + after); after += l1m;
            for (int e = 0; e < 32; ++e) o[e] += w * bf2f(Z[(size_t)s * LDZ + ZC_VB + hd * 128 + d0 + e]);
            if (after < -120.f) break; }
        for (int e = 0; e < 32; ++e) EXP[t * 128 + d0 + e] = o[e];
        __threadfence(); __syncthreads();
    }
    GRID_SYNC();
#endif
#if DIAG == 11
    if (blockIdx.x == 0) {
        const int tid = fresh_tid();
        float* EXP = (float*)(ws + 460 * MiB); float* BB = EXP + 128 * 256; float* ST = BB + 128 * 128;
        const float* LRp = (const float*)(ws + WS_LR);
        for (int i = tid; i < 128 * 128; i += 512) { const int t = i >> 7, d = i & 127; float pre = P.b_alpha[d];
            for (int r = 0; r < 16; ++r) pre += LRp[t * 16 + r] * P.w_alpha[r * 512 + d];
            const float ls = fminf(pre, 0.f) - log1pf(expf(-fabsf(pre))); BB[i] = ls / 16.f; }
        __threadfence(); __syncthreads();
        if (tid < 256) { const int d = tid & 127, ch = tid >> 7; float run = 0.f; for (int t = 0; t < 64; ++t) { run += BB[(ch * 64 + t) * 128 + d]; BB[(ch * 64 + t) * 128 + d] = run; } }
        __threadfence(); __syncthreads();
        const float sc = 0.08838834764831845f;
        for (int i = tid; i < 64 * 256; i += 512) { const int t = i >> 8, dv = i & 255; float o = 0.f;
            for (int s = 0; s < 64; ++s) { float a = 0.f; for (int d = 0; d < 128; ++d) { const float q = bf2f(Z[(size_t)t * LDZ + d]) * sc, k = bf2f(Z[(size_t)s * LDZ + 512 + d]);
                    a += q * k * expf(-fabsf(BB[t * 128 + d] - BB[s * 128 + d])); }
                o += a * bf2f(Z[(size_t)s * LDZ + 1024 + dv]); }
            EXP[t * 256 + dv] = o; }
        for (int i = tid; i < 128 * 256; i += 512) { const int d = i >> 8, dv = i & 255; float s_ = 0.f;
            for (int s = 0; s < 64; ++s) s_ += bf2f(Z[(size_t)s * LDZ + 512 + d]) * expf(BB[63 * 128 + d] - BB[s * 128 + d]) * bf2f(Z[(size_t)s * LDZ + 1024 + dv]);
            ST[i] = s_; }
        __threadfence(); __syncthreads();
        for (int i = tid; i < 64 * 256; i += 512) { const int t = 64 + (i >> 8), dv = i & 255; float o = 0.f;
            for (int s = 64; s < 128; ++s) { float a = 0.f; for (int d = 0; d < 128; ++d) { const float q = bf2f(Z[(size_t)t * LDZ + d]) * sc, k = bf2f(Z[(size_t)s * LDZ + 512 + d]);
                    a += q * k * expf(-fabsf(BB[t * 128 + d] - BB[s * 128 + d])); }
                o += a * bf2f(Z[(size_t)s * LDZ + 1024 + dv]); }
            for (int d = 0; d < 128; ++d) o += bf2f(Z[(size_t)t * LDZ + d]) * sc * expf(BB[t * 128 + d]) * ST[d * 256 + dv];
            EXP[t * 256 + dv] = o; }
        __threadfence(); __syncthreads();
    }
    GRID_SYNC();
#endif
#if DIAG != 3 && DIAG != 4 && DIAG != 8 && DIAG != 5 && DIAG != 6
    { const int tid = fresh_tid(); for (int u = blockIdx.x; u < 2048; u += G) gla_prep_unit(P, lds, u, tid); }
    { const int tid = fresh_tid(); for (int u = blockIdx.x; u < 1024; u += G) sb_unit(P, lds, u, tid); }
    }
    if (BOTH(2)) GRID_SYNC();
    if (IN(3)) {
#if DIAG == 10
    { const int tid = fresh_tid(); const bf16_t* ATTd = (const bf16_t*)(ws + WS_ATTN); const float* DECd = (const float*)(ws + WS_DEC);
      for (size_t i = (size_t)blockIdx.x * 512 + tid; i < (size_t)NTOK * 1024; i += (size_t)G * 512) { const size_t r = i >> 10, c = i & 1023;
          P.out[i] = bf2f(Z[r * LDZ + c]) + 2.f * bf2f(ATTd[i & 0x7FFFFF]) + 4.f * DECd[i & 0x3FFFF]; } return; }
#endif
    {
        const int tid = fresh_tid(); const int wave = __builtin_amdgcn_readfirstlane(tid >> 6), lane = tid & 63;
        if (wave < 4) for (int u = blockIdx.x; u < 256; u += G) gla_scan_unit(P, lds, u, wave, lane);
    }
#endif
    }
    if (BOTH(3)) GRID_SYNC();
    if (IN(4)) {
#if DIAG == 7
    { const int tid = fresh_tid(); const float* SSAd = (const float*)(ws + WS_SSA);
      for (size_t i = (size_t)blockIdx.x * 512 + tid; i < (size_t)NTOK * 1024; i += (size_t)G * 512) { const size_t r = i >> 10, c = i & 1023;
#if DIAG7_SEL == 0
          P.out[i] = bf2f(Z[r * LDZ + ZC_OB + c]); } return; }
#elif DIAG7_SEL == 1
          P.out[i] = bf2f(Z[r * LDZ + ZC_OA + c]); } return; }
#else
          P.out[i] = SSAd[r * 64 + (c & 63)]; } return; }
#endif
#endif
#if DIAG == 13
    { const int tid = fresh_tid(); float* SC = (float*)(ws + 460 * MiB) + (size_t)blockIdx.x * 4096; const size_t r0 = (size_t)blockIdx.x * 128 + 37;
      if (blockIdx.x == 0 && tid == 0) { *(unsigned*)(ws + 500 * MiB) = 0u; *((unsigned*)(ws + 500 * MiB) + 64) = 0u; }
        for (int i = tid; i < 1024; i += 512) { SC[i] = bf2f(Z[r0 * LDZ + ZC_OA + i]); SC[1024 + i] = bf2f(Z[r0 * LDZ + ZC_OB + i]); }
        if (tid < 64) SC[2048 + tid] = ((const float*)(ws + WS_SSA))[r0 * 64 + tid];
        __threadfence(); __syncthreads(); }
    GRID_SYNC();
#endif
#if DIAG == 15
    {   const int tid = fresh_tid(); const float* EXP = (const float*)(ws + 470 * MiB); LAS float* red = (LAS float*)lds; float* PC = (float*)(ws + 500 * MiB + 4096);
        if (blockIdx.x < 128) { const int c = blockIdx.x; float se = 0.f, sr = 0.f;
            for (int i = tid; i < 64 * 256; i += 512) { const size_t t = (size_t)c * 64 + (i >> 8); const int dv = i & 255;
                const float e = EXP[t * 256 + dv], g = bf2f(Z[((size_t)DIAG_B * SEQ + t) * LDZ + ZC_OA + DIAG_H * 256 + dv]); se += (e - g) * (e - g); sr += e * e; }
            red[tid] = se; red[512 + tid] = sr; __syncthreads();
            if (tid == 0) { float a = 0.f, b = 0.f; for (int i = 0; i < 512; ++i) { a += red[i]; b += red[512 + i]; } PC[c] = sqrtf(a / b); }
        }
        __threadfence(); __syncthreads();
    }
    GRID_SYNC();
    { const int tid = fresh_tid(); const float* PC = (const float*)(ws + 500 * MiB + 4096); int cnt = 0;
      for (int c = 0; c < 128; ++c) { const float v = __hip_atomic_load(PC + c, __ATOMIC_RELAXED, __HIP_MEMORY_SCOPE_AGENT); if (v > 0.03f) ++cnt; }
      const float cst = (float)cnt;
      for (size_t i = (size_t)blockIdx.x * 512 + tid; i < (size_t)NTOK * 1024; i += (size_t)G * 512) P.out[i] = cst; }
    return;
#endif
#if DIAG == 12
    {   const int tid = fresh_tid(); const float* EXP = (const float*)(ws + 470 * MiB); int bad = 0; unsigned badrow = 0;
        for (size_t i = (size_t)blockIdx.x * 512 + tid; i < (size_t)NTOK * 128; i += (size_t)G * 512) { const size_t t = i >> 7; const int d = (int)(i & 127);
            const float e = EXP[i], g = bf2f(Z[t * LDZ + ZC_OB + DIAG_HD * 128 + d]); if (fabsf(e - g) > 0.05f) { ++bad; badrow = (unsigned)(t & 8191) + 1u; } }
        if (bad) { atomicAdd((unsigned*)(ws + 500 * MiB), (unsigned)bad); atomicMax((unsigned*)(ws + 500 * MiB) + 64, badrow); }
        __threadfence(); __syncthreads();
    }
    GRID_SYNC();
    { const int tid = fresh_tid(); const float cst = (float)__hip_atomic_load((const unsigned*)(ws + 500 * MiB) + DIAG13_WHICH * 64, __ATOMIC_RELAXED, __HIP_MEMORY_SCOPE_AGENT);
      for (size_t i = (size_t)blockIdx.x * 512 + tid; i < (size_t)NTOK * 1024; i += (size_t)G * 512) P.out[i] = cst; }
    return;
#endif
#if DIAG == 11
    {
        const int tid = fresh_tid(); const float* EXP = (const float*)(ws + 460 * MiB);
        LAS float* red = (LAS float*)lds;
        float md = 0.f, mx = 0.f;
        for (int i = tid; i < 128 * 256; i += 512) { const int t = i >> 8, dv = i & 255; const float e = EXP[i], g = bf2f(Z[(size_t)t * LDZ + ZC_OA + dv]); md = fmaxf(md, fabsf(e - g)); mx = fmaxf(mx, fabsf(e)); }
        red[tid] = md; red[512 + tid] = mx; __syncthreads();
        if (tid == 0) { float a = 0.f, b = 0.f; for (int i = 0; i < 512; ++i) { a = fmaxf(a, red[i]); b = fmaxf(b, red[512 + i]); } red[1024] = 1.f + 100.f * a / fmaxf(b, 1e-20f); }
        __syncthreads();
        const float cst = red[1024];
        for (size_t i = (size_t)blockIdx.x * 512 + tid; i < (size_t)NTOK * 1024; i += (size_t)G * 512) P.out[i] = cst;
        return;
    }
#endif
    {
        pg8::Gemm g{H, (const bf16_t*)(ws + WS_W4T), H, (const bf16_t*)(ws + WS_W4T), NTOK, 4096, 1024, 1024};
        pg8::StaticOrder S; S.init(NTOK, 4096, G, (int)blockIdx.x);
        EpiGates E{Z, (const float*)(ws + WS_SSA), P.g_gla, Z, (bf16_t*)(ws + (DIAG == 8 ? 448 : 416) * MiB)};
        pg8::gemm_phase<EpiGates, pg8::StaticOrder, true, true>(lds, g, S, E);
    }
    }
    if (BOTH(4)) GRID_SYNC();
    if (IN(5)) {
#if DIAG == 8
    {
        const int tid = fresh_tid(); const bf16_t* SGX = (const bf16_t*)(ws + 448 * MiB);
        for (size_t i = (size_t)blockIdx.x * 512 + tid; i < (size_t)NTOK * 1024; i += (size_t)G * 512) P.out[i] = bf2f(SGX[i]);
        return;
    }
#endif
#if DIAG == 4
    {
        const int tid = fresh_tid();
        for (size_t i = (size_t)blockIdx.x * 512 + tid; i < (size_t)NTOK * 1024; i += (size_t)G * 512) { const size_t r = i >> 10, c = i & 1023;
            const unsigned sgw = __hip_atomic_load((const unsigned*)P.out + i, __ATOMIC_RELAXED, __HIP_MEMORY_SCOPE_AGENT);
#if DIAG4_SGONLY
            P.out[i] = bflo(sgw) + bfhi(sgw); }
#else
            P.out[i] = bf2f(Z[r * LDZ + ZC_OA + c]) + bf2f(Z[r * LDZ + ZC_OB + c]) + bflo(sgw) + bfhi(sgw); }
#endif
        return;
    }
#endif
#if DIAG == 6
    { const int tid = fresh_tid(); for (size_t i = (size_t)blockIdx.x * 512 + tid; i < (size_t)NTOK * 1024; i += (size_t)G * 512) { const size_t r = i >> 10, c = i & 1023; P.out[i] = bf2f(Z[r * LDZ + c]); } return; }
#endif
    {
        pg8::Gemm g{Z + ZC_OA, (const bf16_t*)(ws + WS_WG), Z + ZC_OB, (const bf16_t*)(ws + WS_WS), NTOK, 1024, 1024, LDZ};
        PairOrder S; S.init(NTOK, 1024, G, (int)blockIdx.x);
        EpiMerge E{Z + ZC_VA, Z};
        pg8::gemm_phase<EpiMerge, PairOrder, true, true>(lds, g, S, E);
    }
    }
    if (BOTH(5)) GRID_SYNC();
    if (IN(6)) {
#if DIAG == 6
#endif
#if DIAG == 5
    { const int tid = fresh_tid(); for (size_t i = (size_t)blockIdx.x * 512 + tid; i < (size_t)NTOK * 1024; i += (size_t)G * 512) { const size_t r = i >> 10, c = i & 1023; P.out[i] = bf2f(Z[r * LDZ + ZC_VA + c]); } return; }
#endif
    {
        pg8::Gemm g{Z + ZC_VA, (const bf16_t*)(ws + WS_WO), Z + ZC_VA, (const bf16_t*)(ws + WS_WO), NTOK, 1024, 1024, LDZ};
        pg8::StaticOrder S; S.init(NTOK, 1024, G, (int)blockIdx.x);
        EpiX1 E{P.x, Z, (float*)(ws + WS_SS1)};
        pg8::gemm_phase<EpiX1, pg8::StaticOrder, true, true>(lds, g, S, E);
    }
    }
    if (BOTH(6)) GRID_SYNC();
    if (IN(7)) {
    {
        pg8::Gemm g{(const bf16_t*)(ws + WS_PB), (const bf16_t*)(ws + WS_WPE), (const bf16_t*)(ws + WS_PB), (const bf16_t*)(ws + WS_WPE), NTOK, 1024, 256, 256};
        pg8::StaticOrder S; S.init(NTOK, 1024, G, (int)blockIdx.x);
        EpiPE E{Z};
        pg8::gemm_phase<EpiPE, pg8::StaticOrder, true, true>(lds, g, S, E);
    }
    {
        pg8::Gemm g{Z, (const bf16_t*)(ws + WS_WPG), Z, (const bf16_t*)(ws + WS_WPG), NTOK, 1024, 1024, LDZ};
        pg8::StaticOrder S; S.init(NTOK, 1024, G, (int)blockIdx.x);
        EpiX2 E{Z, (const float*)(ws + WS_SS1), (float*)(ws + WS_SS2)};
        pg8::gemm_phase<EpiX2, pg8::StaticOrder, true, true>(lds, g, S, E);
    }
    }
    if (BOTH(7)) GRID_SYNC();
    if (IN(8)) {
    {
        const int tid = fresh_tid(); const int wave = tid >> 6, lane = tid & 63;
        const float* SS2 = (const float*)(ws + WS_SS2);
        for (int m = blockIdx.x * 8 + wave; m < NTOK; m += G * 8) {
            const f32x4* sp = (const f32x4*)(SS2 + (size_t)m * 16); const f32x4 a = sp[0], b = sp[1], c4 = sp[2], d = sp[3];
            const float s = ((a.x + a.y) + (a.z + a.w)) + ((b.x + b.y) + (b.z + b.w)) + ((c4.x + c4.y) + (c4.z + c4.w)) + ((d.x + d.y) + (d.z + d.w));
            const float rstd = rsqrtf(s * (1.f / 1024.f) + EPS);
            const f32x4* xi = (const f32x4*)(Z + (size_t)m * LDZ + 2048) + lane; f32x4* xr = (f32x4*)(P.out + (size_t)m * DM) + lane;
#pragma unroll
            for (int j = 0; j < 4; ++j) { const f32x4 g4 = ((const f32x4*)P.g_final)[64 * j + lane]; xr[64 * j] = xi[64 * j] * rstd * g4; }
        }
    }
    }
#if DIAG == 13
    GRID_SYNC();
    {
        const int tid = fresh_tid(); const size_t r0 = (size_t)blockIdx.x * 128 + 37; const float* SC = (const float*)(ws + 460 * MiB) + (size_t)blockIdx.x * 4096; float* T = (float*)(ws + 470 * MiB) + (size_t)blockIdx.x * 16384;
        float* hrow = T, *A1 = T + 1024, *A2 = T + 2048, *mg = T + 3072, *x1 = T + 4096, *uu = T + 5120, *x2 = T + 6144, *sm = T + 7168, *red = T + 9216;
        for (int i = tid; i < 1024; i += 512) hrow[i] = bf2f(H[r0 * 1024 + i]);
        __threadfence(); __syncthreads();
        for (int n = tid; n < 4096; n += 512) { const int col = (n < 1024) ? 2064 + n : (n < 2048 ? 6160 + (n - 1024) : 7184 + (n - 2048)); float s = 0.f;
            for (int k = 0; k < 1024; ++k) s += hrow[k] * P.w_in[(size_t)k * 9232 + col];
            if (n < 1024) { float ss = 0.f; for (int j = 0; j < 16; ++j) ss += SC[2048 + (n >> 8) * 16 + j]; const float rstd = rsqrtf(ss / 256.f + EPS);
                A1[n] = SC[n] * rstd * P.g_gla[n] * (s / (1.f + expf(-s))); }
            else if (n < 2048) A2[n - 1024] = SC[1024 + (n - 1024)] * (s / (1.f + expf(-s)));
            else sm[n - 2048] = 1.f / (1.f + expf(-s)); }
        __threadfence(); __syncthreads();
        for (int n = tid; n < 1024; n += 512) { float ya = 0.f, yb = 0.f; for (int k = 0; k < 1024; ++k) { ya += A1[k] * P.w_out_gla[(size_t)k * 1024 + n]; yb += A2[k] * P.w_out_sb[(size_t)k * 1024 + n]; }
            mg[n] = sm[n] * ya + sm[1024 + n] * yb; }
        __threadfence(); __syncthreads();
        for (int n = tid; n < 1024; n += 512) { float s = 0.f; for (int k = 0; k < 1024; ++k) s += mg[k] * P.w_out[(size_t)k * 1024 + n]; x1[n] = P.x[r0 * 1024 + n] + s; }
        __threadfence(); __syncthreads();
        if (tid == 0) { float ss = 0.f; for (int k = 0; k < 1024; ++k) ss += x1[k] * x1[k]; red[0] = rsqrtf(ss / 1024.f + EPS); }
        __threadfence(); __syncthreads();
        for (int n = tid; n < 1024; n += 512) uu[n] = x1[n] * red[0] * P.g_ple[n];
        __threadfence(); __syncthreads();
        for (int n = tid; n < 1024; n += 512) { float s = 0.f, pe = 0.f; for (int k = 0; k < 1024; ++k) s += uu[k] * P.w_ple_gate[(size_t)k * 1024 + n];
            for (int k = 0; k < 256; ++k) pe += P.p[r0 * 256 + k] * P.w_ple[(size_t)k * 1024 + n];
            x2[n] = x1[n] + pe / (1.f + expf(-s)); }
        __threadfence(); __syncthreads();
        if (tid == 0) { float ss = 0.f; for (int k = 0; k < 1024; ++k) ss += x2[k] * x2[k]; const float rs = rsqrtf(ss / 1024.f + EPS); float md = 0.f, mx = 0.f;
            for (int k = 0; k < 1024; ++k) { const float e = x2[k] * rs * P.g_final[k]; md = fmaxf(md, fabsf(e - P.out[r0 * 1024 + k])); mx = fmaxf(mx, fabsf(e)); }
            if (md / mx > 0.05f) { atomicAdd((unsigned*)(ws + 500 * MiB), 1u); atomicMax((unsigned*)(ws + 500 * MiB) + 64, (unsigned)blockIdx.x + 1u); } }
        __threadfence(); __syncthreads();
    }
    GRID_SYNC();
    { const int tid = fresh_tid(); const float cst = (float)__hip_atomic_load((const unsigned*)(ws + 500 * MiB) + DIAG13_WHICH * 64, __ATOMIC_RELAXED, __HIP_MEMORY_SCOPE_AGENT);
      for (size_t i = (size_t)blockIdx.x * 512 + tid; i < (size_t)NTOK * 1024; i += (size_t)G * 512) P.out[i] = cst; }
#endif
}

extern "C" void kernel_launch(void* const* d_in, const int* in_sizes, int n_in, void* d_out, int out_size, void* d_ws, size_t ws_size, hipStream_t stream) {
    static int grid = 0;
    if (grid == 0) {
        int dev = 0, cus = 0, per_cu = 0;
        hipGetDevice(&dev);
        hipDeviceGetAttribute(&cus, hipDeviceAttributeMultiprocessorCount, dev);
        hipFuncSetAttribute((const void*)fwd_kernel, hipFuncAttributeMaxDynamicSharedMemorySize, LDS_BYTES);
        hipOccupancyMaxActiveBlocksPerMultiprocessor(&per_cu, (const void*)fwd_kernel, 512, LDS_BYTES);
        if (per_cu < 1) per_cu = 1;
        grid = cus * per_cu;
        if (ws_size < 460 * MiB) fprintf(stderr, "kernel_launch: workspace too small: %zu\n", ws_size);
    }
#if !USE_CG_SYNC
    (void)hipMemsetAsync(d_ws, 0, 1 << 20, stream);
#endif
    Params p{};
    p.x = (const float*)d_in[0]; p.p = (const float*)d_in[1]; p.g_mix = (const float*)d_in[2]; p.w_in = (const float*)d_in[3];
    p.w_alpha = (const float*)d_in[4]; p.b_alpha = (const float*)d_in[5]; p.g_gla = (const float*)d_in[6]; p.w_out_gla = (const float*)d_in[7];
    p.w_out_sb = (const float*)d_in[8]; p.w_out = (const float*)d_in[9]; p.g_ple = (const float*)d_in[10]; p.w_ple_gate = (const float*)d_in[11];
    p.w_ple = (const float*)d_in[12]; p.g_final = (const float*)d_in[13];
    p.out = (float*)d_out; p.ws = (unsigned char*)d_ws;
#if N_LAUNCHES == 1
    p.ph_lo = 0; p.ph_hi = 9;
    void* args[] = {&p};
    hipError_t e = hipLaunchCooperativeKernel((const void*)fwd_kernel, dim3(grid), dim3(512), args, LDS_BYTES, stream);
    if (e != hipSuccess) fprintf(stderr, "cooperative launch failed: %s (grid %d)\n", hipGetErrorString(e), grid);
#else
    for (int k = 0; k < 9; ++k) { p.ph_lo = k; p.ph_hi = k + 1; hipLaunchKernelGGL(fwd_kernel, dim3(grid), dim3(512), LDS_BYTES, stream, p); }
#endif
}
```

```cpp
#include <hip/hip_runtime.h>
#include <hip/hip_cooperative_groups.h>
#include <cstdio>
#include <cstdint>
namespace cg = cooperative_groups;
namespace pg8 {
#define PG8_LAS __attribute__((address_space(3)))
typedef unsigned short bf16_t;
typedef short bf16x8 __attribute__((ext_vector_type(8)));
typedef float f32x4 __attribute__((ext_vector_type(4)));
typedef unsigned u32x4 __attribute__((ext_vector_type(4)));
constexpr int BM = 256, BK = 64, HALF = 128, HTB = HALF * BK * 2  , STAGE_BYTES = 8 * HTB, NXCD = 8, WGM = 8;

__host__ __device__ __forceinline__ int lds_byte(int r, int c) { const int st = (r >> 4) * 2 + (c >> 5), rr = r & 15, cc = c & 31, ob = rr * 64 + cc * 2; return st * 1024 + (ob ^ (((ob >> 9) & 1) << 5)); }
__host__ __device__ __forceinline__ void stage_rc(int b, int& R, int& C) { const int st = b / 1024, sb = b % 1024, swz = sb ^ (((sb >> 9) & 1) << 5); R = (st >> 1) * 16 + swz / 64; C = (st & 1) * 32 + (swz % 64) / 2; }
__host__ __device__ __forceinline__ int perm32(int rho) { const int n = rho >> 4, i = rho & 15; return 8 * (i >> 2) + 4 * n + (i & 3); }

struct Unit { int pm, pn, sel; };
struct Gemm { const bf16_t* A; const bf16_t* Bt; const bf16_t* A2; const bf16_t* Bt2; int M, N, K, lda; };

struct StaticOrder {
    int nM, nN, nwg, G, c;
    __host__ __device__ void init(int M, int N, int G_, int c_) { nM = M / BM; nN = N / BM; nwg = nM * nN; G = G_; c = c_; }
    __host__ __device__ bool next(int i, Unit& u) const {
        const long L = (long)i * G + c; if (L >= nwg) return false;
        int wgid = (int)L; { const int q = nwg / NXCD, r = nwg % NXCD, xcd = wgid % NXCD, off = wgid / NXCD; wgid = (xcd < r ? xcd * (q + 1) : r * (q + 1) + (xcd - r) * q) + off; }
        const int nig = WGM * nN, gid = wgid / nig, fm = gid * WGM, gsz = (nM - fm) < WGM ? (nM - fm) : WGM;
        u.pm = fm + ((wgid % nig) % gsz); u.pn = (wgid % nig) / gsz; u.sel = 0; return true;
    }
    __device__ __forceinline__ void a_ready(const Unit&) const {}
    __device__ __forceinline__ void done(const Unit&) const {}
};

__device__ __forceinline__ unsigned cvt_pk_bf16(float lo, float hi) { unsigned r; asm volatile("v_cvt_pk_bf16_f32 %0, %1, %2" : "=v"(r) : "v"(lo), "v"(hi)); return r; }
typedef float f32x2 __attribute__((ext_vector_type(2)));
__device__ __forceinline__ f32x2 gelu_pk(f32x2 v) {
    const f32x2 av = __builtin_elementwise_abs(v), d = av * 0.2316418882f + 1.0f;
    f32x2 t; t.x = __builtin_amdgcn_rcpf(d.x); t.y = __builtin_amdgcn_rcpf(d.y);
    f32x2 q = t * 0.5307027145f + (-0.7265760135f); q = q * t + 0.7107068705f; q = q * t + (-0.142248368f); q = q * t + 0.127414796f; q = q * t;
    const f32x2 s = (v * v) * (-0.72134752044f);
    f32x2 e; e.x = __builtin_amdgcn_exp2f(s.x); e.y = __builtin_amdgcn_exp2f(s.y);
    const f32x2 m = v * (q * e), r = v - m;
    f32x2 o; o.x = v.x < 0.f ? m.x : r.x; o.y = v.y < 0.f ? m.y : r.y; return o;
}

template <int ACT  > struct EpiBf16 {
    static constexpr bool PERM = true, AFTER_DRAIN = false; static_assert(ACT == 0 || ACT == 1, "EpiBf16: ACT is 0 (none) or 1 (gelu_pk)");
    bf16_t* O; int ldc; const float* bias; int split_cols; size_t split_stride; float scale0;
    __device__ __forceinline__ void operator()(const f32x4 (&acc)[2][2][4][2], const Unit& u, int wr, int wc, int fr, int fq) const {
        const int row0 = u.pm * BM + wr * 64 + fr; int colt = u.pn * BM; bf16_t* base = O;
        float sc = 1.f; if (split_cols) { const int t = colt / split_cols; base += (size_t)t * split_stride; colt -= t * split_cols; if (t == 0) sc = scale0; }
        const int col0 = colt + wc * 32 + 8 * fq, bcol0 = u.pn * BM + wc * 32 + 8 * fq;
        f32x4 bv[2][2];
#pragma unroll
        for (int bj = 0; bj < 2; ++bj)
#pragma unroll
            for (int n = 0; n < 2; ++n) bv[bj][n] = bias ? *(const f32x4*)(bias + bcol0 + bj * HALF + 4 * n) : (f32x4){0.f, 0.f, 0.f, 0.f};
#pragma unroll
        for (int ai = 0; ai < 2; ++ai)
#pragma unroll
            for (int m = 0; m < 4; ++m) { bf16_t* rowp = base + (size_t)(row0 + ai * HALF + m * 16) * ldc + col0;
#pragma unroll
                for (int bj = 0; bj < 2; ++bj) { f32x4 v0 = acc[ai][bj][m][0] + bv[bj][0], v1 = acc[ai][bj][m][1] + bv[bj][1];
                    if (ACT == 1) { f32x2 a = gelu_pk((f32x2){v0[0], v0[1]}), b = gelu_pk((f32x2){v0[2], v0[3]}), c = gelu_pk((f32x2){v1[0], v1[1]}), d = gelu_pk((f32x2){v1[2], v1[3]});
                        v0 = (f32x4){a.x, a.y, b.x, b.y}; v1 = (f32x4){c.x, c.y, d.x, d.y}; }
                    v0 = v0 * sc; v1 = v1 * sc; u32x4 w; w.x = cvt_pk_bf16(v0[0], v0[1]); w.y = cvt_pk_bf16(v0[2], v0[3]); w.z = cvt_pk_bf16(v1[0], v1[1]); w.w = cvt_pk_bf16(v1[2], v1[3]);
                    *(u32x4*)(rowp + bj * HALF) = w; } }
    }
};

struct PanelStats {
    unsigned* xbuf;
    unsigned* cnt;
    unsigned* tmo;
    int ntn; float eps;
    unsigned code;
    __device__ __forceinline__ bool run(const f32x4 (&v)[2][2][4][2], const Unit& u, int wr, int wc, int fr, int fq, PG8_LAS unsigned char* lds, int wid, int lane) const {
        typedef float f32x2v __attribute__((ext_vector_type(2)));
        PG8_LAS f32x2v* P = (PG8_LAS f32x2v*)lds;
        PG8_LAS f32x2v* S = (PG8_LAS f32x2v*)(lds + 8192);
        PG8_LAS unsigned* flag = (PG8_LAS unsigned*)(lds + 8192 + 2048);
#pragma unroll
        for (int ai = 0; ai < 2; ++ai)
#pragma unroll
            for (int m = 0; m < 4; ++m) {
                float s = 0.f;
#pragma unroll
                for (int bj = 0; bj < 2; ++bj)
#pragma unroll
                    for (int n = 0; n < 2; ++n) { const f32x4 x = v[ai][bj][m][n]; s += (x[0] + x[1]) + (x[2] + x[3]); }
                s += __shfl_xor(s, 16); s += __shfl_xor(s, 32);
                const float mw = s * (1.0f / 64.0f); float q = 0.f;
#pragma unroll
                for (int bj = 0; bj < 2; ++bj)
#pragma unroll
                    for (int n = 0; n < 2; ++n) { const f32x4 d = v[ai][bj][m][n] - mw; q += (d[0] * d[0] + d[1] * d[1]) + (d[2] * d[2] + d[3] * d[3]); }
                q += __shfl_xor(q, 16); q += __shfl_xor(q, 32);
                if (fq == 0) P[(ai * HALF + wr * 64 + m * 16 + fr) * 4 + wc] = (f32x2v){mw, q};
            }
        asm volatile("s_waitcnt lgkmcnt(0)" ::: "memory"); __builtin_amdgcn_s_barrier(); asm volatile("" ::: "memory");
#if defined(BROKEN_EXCHANGE_NO_WAIT)
#warning BROKEN CONTROL BUILD: the row-statistics exchange does not wait; results are wrong by design
        if (blockIdx.x >= 64) { const long long t0_ = clock64(); while (clock64() - t0_ < 60000) __builtin_amdgcn_s_sleep(8); }
#endif
        const int row = wid * 32 + (lane & 31);
        if (lane < 32) {
            const f32x2v a = P[row * 4 + 0], b = P[row * 4 + 1], c = P[row * 4 + 2], d = P[row * 4 + 3];
            const float mt = (a.x + b.x + c.x + d.x) * 0.25f;
            const float da = a.x - mt, db = b.x - mt, dc = c.x - mt, dd = d.x - mt;
            const float m2 = (a.y + b.y) + (c.y + d.y) + 64.0f * ((da * da + db * db) + (dc * dc + dd * dd));
            unsigned long long* slot = (unsigned long long*)xbuf + ((size_t)(u.pm * BM + row) * 4 + u.pn);
            __hip_atomic_store(slot, ((unsigned long long)__float_as_uint(m2) << 32) | __float_as_uint(mt), __ATOMIC_RELAXED, __HIP_MEMORY_SCOPE_AGENT);
        }
        asm volatile("s_waitcnt vmcnt(0)" ::: "memory");
        if (lane == 0) __hip_atomic_fetch_add(cnt + 64 * u.pm, 1u, __ATOMIC_RELAXED, __HIP_MEMORY_SCOPE_AGENT);
        if (wid == 0) {
            bool dead = false; const unsigned long long t0 = __builtin_amdgcn_s_memrealtime(); const unsigned want = 8u * (unsigned)ntn;
            for (;;) {
#if defined(BROKEN_EXCHANGE_NO_WAIT)
                break;
#endif
                if ((unsigned)__builtin_amdgcn_readfirstlane(__hip_atomic_load(cnt + 64 * u.pm, __ATOMIC_RELAXED, __HIP_MEMORY_SCOPE_AGENT)) >= want) break;
                if (__builtin_amdgcn_s_memrealtime() - t0 > 2000000ull) {
                    if (lane == 0) { unsigned expect = 0u; __hip_atomic_compare_exchange_strong(tmo + 1, &expect, code | (unsigned)(u.pm & 0xff), __ATOMIC_RELAXED, __ATOMIC_RELAXED, __HIP_MEMORY_SCOPE_AGENT);
                                     __hip_atomic_store(tmo, 1u, __ATOMIC_RELAXED, __HIP_MEMORY_SCOPE_AGENT); }
                    dead = true; break; }
                __builtin_amdgcn_s_sleep(2);
            }
            __builtin_amdgcn_fence(__ATOMIC_ACQUIRE, "agent");
            if (lane == 0) flag[0] = dead ? 1u : 0u;
        }
        asm volatile("s_waitcnt vmcnt(0) lgkmcnt(0)" ::: "memory"); __builtin_amdgcn_s_barrier(); asm volatile("" ::: "memory");
        const bool bad = flag[0] != 0u;
        if (lane < 32) {
            const unsigned long long* slot = (const unsigned long long*)xbuf + (size_t)(u.pm * BM + row) * 4; float mt[4], m2[4]; float ms = 0.f;
#pragma unroll
            for (int t = 0; t < 4; ++t) { if (t < ntn) { const unsigned long long w = __hip_atomic_load(slot + t, __ATOMIC_RELAXED, __HIP_MEMORY_SCOPE_AGENT); mt[t] = __uint_as_float((unsigned)w); m2[t] = __uint_as_float((unsigned)(w >> 32)); } else { mt[t] = 0.f; m2[t] = 0.f; } ms += mt[t]; }
            const float mean = ms / (float)ntn; float q = 0.f;
#pragma unroll
            for (int t = 0; t < 4; ++t) if (t < ntn) { const float dm = mt[t] - mean; q += m2[t] + 256.0f * dm * dm; }
            S[row] = (f32x2v){mean, 1.0f / sqrtf(q / (256.0f * (float)ntn) + eps)};
        }
        asm volatile("s_waitcnt lgkmcnt(0)" ::: "memory"); __builtin_amdgcn_s_barrier(); asm volatile("" ::: "memory");
        return bad;
    }
};
struct EpiLnRes {
    static constexpr bool PERM = false, AFTER_DRAIN = true;
    const float* base; float* out; int ldc; const float* bias; PanelStats st; unsigned poison;
    __device__ __forceinline__ void fused(f32x4 (&acc)[2][2][4][2], const Unit& u, int wr, int wc, int fr, int fq, PG8_LAS unsigned char* lds, int wid, int lane) const {
        typedef float f32x2v __attribute__((ext_vector_type(2)));
        const PG8_LAS f32x2v* S = (const PG8_LAS f32x2v*)(lds + 8192);
        const int col0 = u.pn * BM + wc * 32 + 4 * fq;
#pragma unroll
        for (int bj = 0; bj < 2; ++bj)
#pragma unroll
            for (int n = 0; n < 2; ++n) { const f32x4 bv = bias ? *(const f32x4*)(bias + col0 + bj * HALF + n * 16) : (f32x4){0.f, 0.f, 0.f, 0.f};
#pragma unroll
                for (int ai = 0; ai < 2; ++ai)
#pragma unroll
                    for (int m = 0; m < 4; ++m) acc[ai][bj][m][n] += bv; }
        f32x4 pre[4][2][2];
#pragma unroll
        for (int m = 0; m < 4; ++m) { const size_t off = (size_t)(u.pm * BM + wr * 64 + m * 16 + fr) * ldc + col0;
#pragma unroll
            for (int bj = 0; bj < 2; ++bj)
#pragma unroll
                for (int n = 0; n < 2; ++n) pre[m][bj][n] = *(const f32x4*)(base + off + bj * HALF + n * 16); }
        const bool bad = st.run(acc, u, wr, wc, fr, fq, lds, wid, lane) || poison != 0u;
        const float qnan = __builtin_nanf("");
#pragma unroll
        for (int ai = 0; ai < 2; ++ai)
#pragma unroll
            for (int m = 0; m < 4; ++m) { const int r = ai * HALF + wr * 64 + m * 16 + fr; const f32x2v sr = S[r]; const size_t off = (size_t)(u.pm * BM + r) * ldc + col0;
#pragma unroll
                for (int bj = 0; bj < 2; ++bj)
#pragma unroll
                    for (int n = 0; n < 2; ++n) { const f32x4 bs = ai == 0 ? pre[m][bj][n] : *(const f32x4*)(base + off + bj * HALF + n * 16); f32x4 o = bs + (acc[ai][bj][m][n] - sr.x) * sr.y;
                        if (bad) o = (f32x4){qnan, qnan, qnan, qnan}; *(f32x4*)(out + off + bj * HALF + n * 16) = o; }
                if (m & 1) asm volatile("" ::: "memory"); }
    }
};
struct EpiLnResLn {
    static constexpr bool PERM = false, AFTER_DRAIN = true;
    const float* base; float* out; bf16_t* xn; int ldc; const float* bias; PanelStats st1, st2; unsigned poison;
    __device__ __forceinline__ void fused(f32x4 (&acc)[2][2][4][2], const Unit& u, int wr, int wc, int fr, int fq, PG8_LAS unsigned char* lds, int wid, int lane) const {
        typedef float f32x2v __attribute__((ext_vector_type(2))); typedef unsigned u32x2v __attribute__((ext_vector_type(2)));
        const PG8_LAS f32x2v* S = (const PG8_LAS f32x2v*)(lds + 8192);
        const int col0 = u.pn * BM + wc * 32 + 4 * fq;
#pragma unroll
        for (int bj = 0; bj < 2; ++bj)
#pragma unroll
            for (int n = 0; n < 2; ++n) { const f32x4 bv = bias ? *(const f32x4*)(bias + col0 + bj * HALF + n * 16) : (f32x4){0.f, 0.f, 0.f, 0.f};
#pragma unroll
                for (int ai = 0; ai < 2; ++ai)
#pragma unroll
                    for (int m = 0; m < 4; ++m) acc[ai][bj][m][n] += bv; }
        bool bad = st1.run(acc, u, wr, wc, fr, fq, lds, wid, lane) || poison != 0u;
        const float qnan = __builtin_nanf("");
#pragma unroll
        for (int ai = 0; ai < 2; ++ai)
#pragma unroll
            for (int m = 0; m < 4; ++m) { const int r = ai * HALF + wr * 64 + m * 16 + fr; const f32x2v sr = S[r]; const size_t off = (size_t)(u.pm * BM + r) * ldc + col0;
#pragma unroll
                for (int bj = 0; bj < 2; ++bj)
#pragma unroll
                    for (int n = 0; n < 2; ++n) { const f32x4 bs = *(const f32x4*)(base + off + bj * HALF + n * 16); acc[ai][bj][m][n] = bs + (acc[ai][bj][m][n] - sr.x) * sr.y; }
                asm volatile("" : "+v"(acc[ai][0][m][0]), "+v"(acc[ai][0][m][1]), "+v"(acc[ai][1][m][0]), "+v"(acc[ai][1][m][1]));
                if (m & 1) asm volatile("" ::: "memory"); }
        const bool bad1 = bad;
        bad = st2.run(acc, u, wr, wc, fr, fq, lds, wid, lane) || bad;
#pragma unroll
        for (int ai = 0; ai < 2; ++ai)
#pragma unroll
            for (int m = 0; m < 4; ++m) { const int r = ai * HALF + wr * 64 + m * 16 + fr; const f32x2v sr = S[r]; const size_t off = (size_t)(u.pm * BM + r) * ldc + col0;
#pragma unroll
                for (int bj = 0; bj < 2; ++bj)
#pragma unroll
                    for (int n = 0; n < 2; ++n) { const f32x4 x1 = acc[ai][bj][m][n]; *(f32x4*)(out + off + bj * HALF + n * 16) = bad1 ? (f32x4){qnan, qnan, qnan, qnan} : x1;
                        const f32x4 o = (x1 - sr.x) * sr.y; u32x2v w; w.x = cvt_pk_bf16(o[0], o[1]); w.y = cvt_pk_bf16(o[2], o[3]);
                        if (bad) { w.x = 0x7fc07fc0u; w.y = 0x7fc07fc0u; } *(u32x2v*)(xn + off + bj * HALF + n * 16) = w; }
                asm volatile("" ::: "memory"); }
    }
};

template <class Epi, class Sched, bool ALIGN_EPI = false, bool SP2 = false>
__device__ __forceinline__ void gemm_phase(PG8_LAS unsigned char* lds, const Gemm g, const Sched& S, const Epi& E) {
    int tid_ = threadIdx.x; asm volatile("" : "+v"(tid_)); const int tid = tid_, wid = __builtin_amdgcn_readfirstlane(tid >> 6), lane = tid & 63, wr = wid >> 2, wc = wid & 3, fr = lane & 15, fq = lane >> 4;
    const int K = g.K, nt = K / BK;
    unsigned voffA[2], voffB[2];
#pragma unroll
    for (int i = 0; i < 2; ++i) { int R, C; stage_rc(tid * 16 + i * 8192, R, C); const int Rb = Epi::PERM ? ((R & ~31) + perm32(R & 31)) : R;
        voffA[i] = (unsigned)(R * g.lda + C) * 2u; voffB[i] = (unsigned)(Rb * K + C) * 2u; }
    const size_t kstep = (size_t)(BK * 2);
    const size_t hstepA = (size_t)HALF * g.lda * 2, hstepB = (size_t)HALF * K * 2;
    const size_t tstepA = 2 * hstepA, tstepB = 2 * hstepB;
    const unsigned ldsw = (unsigned)wid * 1024u;
    const int aoff = lds_byte(wr * 64 + fr, fq * 8), boff = lds_byte(wc * 32 + fr, fq * 8);
#define PG8_SA(b, h) (((b) * 2 + (h)) * HTB)
#define PG8_SB(b, h) ((4 + (b) * 2 + (h)) * HTB)
#define PG8_STAGE(bufoff, gbase, voff) do { _Pragma("unroll") for (int _i = 0; _i < 2; ++_i) \
        __builtin_amdgcn_global_load_lds((const unsigned*)((const char*)(gbase) + (voff)[_i]), (PG8_LAS unsigned*)(lds + (bufoff) + ldsw + _i * 8192), 16, 0, 0); } while (0)
#define PG8_LDA(dst, b, h) do { _Pragma("unroll") for (int m = 0; m < 4; ++m) _Pragma("unroll") for (int k = 0; k < 2; ++k) dst[m][k] = *(const PG8_LAS bf16x8*)(lds + PG8_SA(b, h) + aoff + m * 2048 + k * 1024); } while (0)
#define PG8_LDB(dst, b, h) do { _Pragma("unroll") for (int n = 0; n < 2; ++n) _Pragma("unroll") for (int k = 0; k < 2; ++k) dst[n][k] = *(const PG8_LAS bf16x8*)(lds + PG8_SB(b, h) + boff + n * 2048 + k * 1024); } while (0)
#define PG8_MMA(ai, bj, At, Bt) do { __builtin_amdgcn_s_setprio(1); _Pragma("unroll") for (int m = 0; m < 4; ++m) _Pragma("unroll") for (int n = 0; n < 2; ++n) _Pragma("unroll") for (int k = 0; k < 2; ++k) \
        acc[ai][bj][m][n] = __builtin_amdgcn_mfma_f32_16x16x32_bf16(Bt[n][k], At[m][k], acc[ai][bj][m][n], 0, 0, 0); __builtin_amdgcn_s_setprio(0); } while (0)
#define PG8_WAIT_V(n) asm volatile("s_waitcnt vmcnt(" #n ")" ::: "memory")
#define PG8_WAIT_L(n) asm volatile("s_waitcnt lgkmcnt(" #n ")" ::: "memory")
#define PG8_BAR __builtin_amdgcn_s_barrier()
#define PG8_SCHED __builtin_amdgcn_sched_barrier(0)
    Unit cur, nxt; int ui = 0;
    if (!S.next(0, cur)) return;
    f32x4 acc[2][2][4][2];
#pragma unroll
    for (int a = 0; a < 2; ++a)
#pragma unroll
        for (int b = 0; b < 2; ++b)
#pragma unroll
            for (int m = 0; m < 4; ++m)
#pragma unroll
                for (int n = 0; n < 2; ++n) acc[a][b][m][n] = (f32x4){0.f, 0.f, 0.f, 0.f};
    bf16x8 At[4][2], B0[2][2], B1[2][2];
    const char* cA = (const char*)(cur.sel ? g.A2 : g.A) + (size_t)cur.pm * tstepA; const char* cB = (const char*)(cur.sel ? g.Bt2 : g.Bt) + (size_t)cur.pn * tstepB;
    S.a_ready(cur);
    if constexpr (SP2) {
        PG8_STAGE(PG8_SB(0, 0), cB, voffB); PG8_STAGE(PG8_SB(0, 1), cB + hstepB, voffB); PG8_STAGE(PG8_SA(0, 0), cA, voffA); PG8_STAGE(PG8_SA(0, 1), cA + hstepA, voffA);
        if (wr == 1) PG8_BAR;
        PG8_WAIT_V(2); PG8_BAR;
        PG8_STAGE(PG8_SB(1, 0), cB + kstep, voffB); PG8_STAGE(PG8_SA(1, 0), cA + kstep, voffA); PG8_STAGE(PG8_SB(1, 1), cB + hstepB + kstep, voffB);
        PG8_WAIT_V(6); PG8_BAR;
    } else {
        PG8_STAGE(PG8_SB(0, 0), cB, voffB); PG8_STAGE(PG8_SA(0, 0), cA, voffA); PG8_STAGE(PG8_SB(0, 1), cB + hstepB, voffB); PG8_STAGE(PG8_SA(0, 1), cA + hstepA, voffA);
        if (wr == 1) PG8_BAR;
        PG8_WAIT_V(4); PG8_BAR;
        PG8_STAGE(PG8_SB(1, 0), cB + kstep, voffB); PG8_STAGE(PG8_SA(1, 0), cA + kstep, voffA); PG8_STAGE(PG8_SB(1, 1), cB + hstepB + kstep, voffB);
        PG8_WAIT_V(6); PG8_BAR;
    }
    for (;;) {
        const bool has_next = S.next(ui + 1, nxt);
        const char* nA = has_next ? (const char*)(nxt.sel ? g.A2 : g.A) + (size_t)nxt.pm * tstepA : cA; const char* nB = has_next ? (const char*)(nxt.sel ? g.Bt2 : g.Bt) + (size_t)nxt.pn * tstepB : cB;
        for (int t = 0; t < nt; t += 2) {
            const bool last = (t == nt - 2);
            const char* a1 = cA + (size_t)(t + 1) * kstep;
            const char* a2 = last ? nA : cA + (size_t)(t + 2) * kstep; const char* b2 = last ? nB : cB + (size_t)(t + 2) * kstep;
            const char* a3 = a2 + kstep; const char* b3 = b2 + kstep;
            if (last && has_next) S.a_ready(nxt);
            if constexpr (SP2) {
            PG8_LDB(B0, 0, 0); PG8_LDB(B1, 0, 1); PG8_SCHED; PG8_LDA(At, 0, 0); PG8_STAGE(PG8_SA(1, 1), a1 + hstepA, voffA);
            PG8_WAIT_V(8); PG8_WAIT_L(0); PG8_BAR; PG8_MMA(0, 0, At, B0); PG8_MMA(0, 1, At, B1); PG8_BAR; PG8_SCHED;
            PG8_LDA(At, 0, 1); PG8_STAGE(PG8_SB(0, 0), b2, voffB); PG8_STAGE(PG8_SB(0, 1), b2 + hstepB, voffB); PG8_STAGE(PG8_SA(0, 0), a2, voffA);
            PG8_WAIT_V(8); PG8_WAIT_L(0); PG8_BAR; PG8_MMA(1, 0, At, B0); PG8_MMA(1, 1, At, B1); PG8_BAR; PG8_SCHED;
            PG8_LDB(B0, 1, 0); PG8_LDB(B1, 1, 1); PG8_SCHED; PG8_LDA(At, 1, 0); PG8_STAGE(PG8_SA(0, 1), a2 + hstepA, voffA);
            PG8_WAIT_V(8); PG8_WAIT_L(0); PG8_BAR; PG8_MMA(0, 0, At, B0); PG8_MMA(0, 1, At, B1); PG8_BAR; PG8_SCHED;
            PG8_LDA(At, 1, 1); PG8_STAGE(PG8_SB(1, 0), b3, voffB); PG8_STAGE(PG8_SB(1, 1), b3 + hstepB, voffB); PG8_STAGE(PG8_SA(1, 0), a3, voffA);
            PG8_WAIT_V(8); PG8_WAIT_L(0); PG8_BAR; PG8_MMA(1, 0, At, B0); PG8_MMA(1, 1, At, B1); PG8_BAR; PG8_SCHED;
            } else {
            PG8_LDB(B0, 0, 0); PG8_SCHED; PG8_LDA(At, 0, 0); PG8_STAGE(PG8_SA(1, 1), a1 + hstepA, voffA);
            PG8_WAIT_L(8); PG8_BAR; PG8_WAIT_L(0); PG8_MMA(0, 0, At, B0); PG8_BAR; PG8_SCHED;
            PG8_LDB(B1, 0, 1); PG8_STAGE(PG8_SB(0, 0), b2, voffB);
            PG8_BAR; PG8_WAIT_L(0); PG8_MMA(0, 1, At, B1); PG8_BAR;
            PG8_LDA(At, 0, 1); PG8_STAGE(PG8_SA(0, 0), a2, voffA);
            PG8_BAR; PG8_WAIT_L(0); PG8_MMA(1, 0, At, B0); PG8_BAR; PG8_SCHED;
            PG8_STAGE(PG8_SB(0, 1), b2 + hstepB, voffB);
            PG8_WAIT_V(6); PG8_BAR; PG8_MMA(1, 1, At, B1); PG8_BAR;
            PG8_LDB(B0, 1, 0); PG8_SCHED; PG8_LDA(At, 1, 0); PG8_STAGE(PG8_SA(0, 1), a2 + hstepA, voffA);
            PG8_WAIT_L(8); PG8_BAR; PG8_WAIT_L(0); PG8_MMA(0, 0, At, B0); PG8_BAR; PG8_SCHED;
            PG8_LDB(B1, 1, 1); PG8_STAGE(PG8_SB(1, 0), b3, voffB);
            PG8_BAR; PG8_WAIT_L(0); PG8_MMA(0, 1, At, B1); PG8_BAR;
            PG8_LDA(At, 1, 1); PG8_STAGE(PG8_SA(1, 0), a3, voffA);
            PG8_BAR; PG8_WAIT_L(0); PG8_MMA(1, 0, At, B0); PG8_BAR; PG8_SCHED;
            PG8_STAGE(PG8_SB(1, 1), b3 + hstepB, voffB);
            PG8_WAIT_V(6); PG8_BAR; PG8_MMA(1, 1, At, B1); PG8_BAR;
            }
        }
        if constexpr (ALIGN_EPI) { if (wr == 0) PG8_BAR; }
        if constexpr (!Epi::AFTER_DRAIN) { E(acc, cur, wr, wc, fr, fq); S.done(cur); }
        if (!has_next) break;
#pragma unroll
        for (int a = 0; a < 2; ++a)
#pragma unroll
            for (int b = 0; b < 2; ++b)
#pragma unroll
                for (int m = 0; m < 4; ++m)
#pragma unroll
                    for (int n = 0; n < 2; ++n) acc[a][b][m][n] = (f32x4){0.f, 0.f, 0.f, 0.f};
        cur = nxt; cA = nA; cB = nB; ++ui;
        if constexpr (ALIGN_EPI) { if (wr == 1) PG8_BAR; }
    }
    PG8_WAIT_V(0);
    if constexpr (!ALIGN_EPI) { if (wr == 0) PG8_BAR; }
    PG8_BAR;
    if constexpr (Epi::AFTER_DRAIN) { E.fused(acc, cur, wr, wc, fr, fq, lds, wid, lane); S.done(cur); }
#undef PG8_SA
#undef PG8_SB
#undef PG8_STAGE
#undef PG8_LDA
#undef PG8_LDB
#undef PG8_MMA
#undef PG8_WAIT_V
#undef PG8_WAIT_L
#undef PG8_BAR
#undef PG8_SCHED
}
}
#define XB_TMO      128
#define XB_XCNT(j)  (256  + 64 * (j))
#define XB_XSUB(j)  (1280 + 64 * (j))
#define XB_XGEN(j)  (2304 + 64 * (j))
#define XB_TOP      3328
#define XB_TOPGEN   3392
#define XCD_BAR_WORDS 3456
#define XB_SPIN_CAP (1u << 18)

__device__ __forceinline__ unsigned xb_ld(unsigned* p)              { return __hip_atomic_load(p, __ATOMIC_RELAXED, __HIP_MEMORY_SCOPE_AGENT); }
__device__ __forceinline__ unsigned xb_add(unsigned* p, unsigned v) { return __hip_atomic_fetch_add(p, v, __ATOMIC_RELAXED, __HIP_MEMORY_SCOPE_AGENT); }
__device__ __forceinline__ unsigned xb_xcc_id() { return (unsigned)__builtin_amdgcn_s_getreg((3 << 11) | 20) & 0xFu; }
#define XB_SPIN(cond, bar) do { unsigned _sp = 0; while (cond) { __builtin_amdgcn_s_sleep(1); \
    if ((++_sp & 255u) == 0u) { if (xb_ld(&(bar)[XB_TMO])) break; if (_sp > XB_SPIN_CAP) { atomicAdd(&(bar)[XB_TMO], 1u); break; } } } } while (0)

struct XcdBarrier {
    unsigned* bar; unsigned x;
    volatile __attribute__((address_space(3))) unsigned* st;
};

__device__ __forceinline__ XcdBarrier xcd_barrier_post(unsigned* bar, volatile __attribute__((address_space(3))) unsigned* st) {
    XcdBarrier b; b.bar = bar; b.x = xb_xcc_id(); b.st = st;
    if (threadIdx.x == 0) (void)xb_add(&bar[XB_XCNT(b.x)], 1u);
    return b;
}
__device__ __forceinline__ void xcd_barrier_complete(unsigned* bar, unsigned x, unsigned& nloc, unsigned& nx) {
    const unsigned G = gridDim.x * gridDim.y * gridDim.z;
    unsigned sum, cnt, mine, sp = 0u;
    for (;;) {
        sum = 0u; cnt = 0u; mine = 0u;
#pragma unroll
        for (unsigned j = 0; j < 16; ++j) { const unsigned c = xb_ld(&bar[XB_XCNT(j)]); sum += c; cnt += (c > 0u) ? 1u : 0u; mine = (j == x) ? c : mine; }
        if (sum == G) break;
        __builtin_amdgcn_s_sleep(1);
        if ((++sp & 255u) == 0u) { if (xb_ld(&bar[XB_TMO])) break; if (sp > XB_SPIN_CAP) { atomicAdd(&bar[XB_TMO], 1u); break; } }
    }
    nloc = mine > 0u ? mine : 1u; nx = cnt > 0u ? cnt : 1u;
}

__device__ __forceinline__ void xcd_barrier(const XcdBarrier& b) {
    asm volatile("s_waitcnt vmcnt(0)" ::: "memory");
    __syncthreads();
    if (threadIdx.x == 0) {
        unsigned* bar = b.bar;
        __builtin_amdgcn_s_waitcnt(0);
        unsigned nloc = b.st[0], nx = b.st[1];
        if (nloc == 0u) { xcd_barrier_complete(bar, b.x, nloc, nx); b.st[0] = nloc; b.st[1] = nx; }
        const unsigned old = xb_add(&bar[XB_XSUB(b.x)], 1u);
        const unsigned gen = old / nloc;
        if (old + 1u == (gen + 1u) * nloc) {
            __builtin_amdgcn_fence(__ATOMIC_RELEASE, "agent");
            asm volatile("s_waitcnt vmcnt(0)" ::: "memory");
            const unsigned og = xb_add(&bar[XB_TOP], 1u);
            const unsigned tg = og / nx;
            if (og + 1u == (tg + 1u) * nx) xb_add(&bar[XB_TOPGEN], 1u);
            else XB_SPIN(xb_ld(&bar[XB_TOPGEN]) == tg, bar);
            __builtin_amdgcn_fence(__ATOMIC_ACQUIRE, "agent");
            xb_add(&bar[XB_XGEN(b.x)], 1u);
            asm volatile("s_waitcnt vmcnt(0)" ::: "memory");
        } else {
            XB_SPIN(xb_ld(&bar[XB_XGEN(b.x)]) == gen, bar);
            __builtin_amdgcn_fence(__ATOMIC_ACQUIRE, "agent");
            asm volatile("s_waitcnt vmcnt(0)" ::: "memory");
        }
    }
    __syncthreads();
}

#define LAS __attribute__((address_space(3)))
typedef unsigned short bf16_t;
typedef short bf16x8 __attribute__((ext_vector_type(8)));
typedef short s16x4 __attribute__((ext_vector_type(4)));
typedef float f32x4 __attribute__((ext_vector_type(4)));
typedef float f32x16 __attribute__((ext_vector_type(16)));
typedef unsigned u32x4 __attribute__((ext_vector_type(4)));
typedef unsigned u32x2 __attribute__((ext_vector_type(2)));

constexpr int NTOK = 32768, DM = 1024, SEQ = 8192, LDZ = 5120;
constexpr float EPS = 1e-6f;
constexpr size_t MiB = (size_t)1 << 20;
constexpr size_t WS_W1T = 1 * MiB, WS_W4T = 12 * MiB, WS_WG = 20 * MiB, WS_WS = 22 * MiB, WS_WO = 24 * MiB, WS_WPG = 26 * MiB, WS_WPE = 28 * MiB;
constexpr size_t WS_LR = 29 * MiB, WS_DEC = 31 * MiB, WS_H = 32 * MiB, WS_Z1 = 96 * MiB, WS_ATTN = 416 * MiB, WS_PB = 432 * MiB, WS_SSA = 448 * MiB, WS_SS1 = 456 * MiB, WS_SS2 = 458 * MiB;
constexpr size_t WS_X1F = 96 * MiB, WS_X1B = 224 * MiB, WS_PE = 288 * MiB;
constexpr int LDS_BYTES = 147456;
#ifndef P5_NO_RMW
#define P5_NO_RMW 0
#endif
#ifndef N_LAUNCHES
#define N_LAUNCHES 1
#endif
#ifndef DIAG7_SEL
#define DIAG7_SEL 0
#endif
#ifndef SCAN_DIRECT_V
#define SCAN_DIRECT_V 2
#endif
#ifndef DIAG13_WHICH
#define DIAG13_WHICH 0
#endif
#ifndef DIAG14_ROW
#define DIAG14_ROW 37
#endif
#ifndef DIAG_HD
#define DIAG_HD 5
#endif
#ifndef DIAG_B
#define DIAG_B 1
#define DIAG_H 2
#endif
#ifndef DIAG_CLO
#define DIAG_CLO 0
#define DIAG_CHI 128
#endif
#ifndef DIAG_T
#define DIAG_T 2
#endif
#ifndef SYS_INV
#define SYS_INV 0
#endif
#ifndef DIAG4_SGONLY
#define DIAG4_SGONLY 1
#endif
#ifndef DIAG
#define DIAG 0
#endif
#ifndef USE_CG_SYNC
#define USE_CG_SYNC 0
#endif
constexpr int ZC_QA = 0, ZC_KA = 512, ZC_VA = 1024, ZC_QB = 2048, ZC_KB = 3072, ZC_VB = 4096, ZC_OA = 3072, ZC_OB = 2048;

struct Params {
    const float* x; const float* p; const float* g_mix; const float* w_in; const float* w_alpha; const float* b_alpha;
    const float* g_gla; const float* w_out_gla; const float* w_out_sb; const float* w_out; const float* g_ple;
    const float* w_ple_gate; const float* w_ple; const float* g_final;
    float* out; unsigned char* ws;
    int ph_lo, ph_hi;
};

__device__ __forceinline__ unsigned cvt_pk(float lo, float hi) { unsigned r; asm volatile("v_cvt_pk_bf16_f32 %0, %1, %2" : "=v"(r) : "v"(lo), "v"(hi)); return r; }
__device__ __forceinline__ bf16_t f2bf(float f) { return (bf16_t)(cvt_pk(f, 0.f) & 0xffffu); }
__device__ __forceinline__ float bf2f(unsigned h) { return __uint_as_float(h << 16); }
__device__ __forceinline__ float bflo(unsigned w) { return __uint_as_float(w << 16); }
__device__ __forceinline__ float bfhi(unsigned w) { return __uint_as_float(w & 0xffff0000u); }
__device__ __forceinline__ float fexp2(float x) { return __builtin_amdgcn_exp2f(x); }
__device__ __forceinline__ float flog2(float x) { return __builtin_amdgcn_logf(x); }
__device__ __forceinline__ float fexp(float x) { return __builtin_amdgcn_exp2f(x * 1.4426950408889634f); }
__device__ __forceinline__ float frcp(float x) { return __builtin_amdgcn_rcpf(x); }
__device__ __forceinline__ float sigmoidf_(float a) { return frcp(1.0f + fexp(-a)); }
__device__ __forceinline__ float siluf_(float a) { return a * sigmoidf_(a); }
__device__ __forceinline__ float logsigmoidf_(float x) { return fminf(x, 0.f) - 0.6931471805599453f * flog2(1.0f + fexp(-fabsf(x))); }
__device__ __forceinline__ float wave_sum(float v) {
#pragma unroll
    for (int o = 1; o < 64; o <<= 1) v += __shfl_xor(v, o);
    return v;
}
__device__ __forceinline__ int fresh_tid() { int t = threadIdx.x; asm volatile("" : "+v"(t)); return t; }
#define LDS_WAIT() asm volatile("s_waitcnt lgkmcnt(0)" ::: "memory")
#define VM_WAIT() asm volatile("s_waitcnt vmcnt(0)" ::: "memory")

__device__ __forceinline__ void p0_item(const float* W, int ldw, int src0, int nv, const float* rs, bf16_t* WT, int K, int n0, int k0, LAS float* scr, int lane) {
    const int c = lane & 31;
#pragma unroll 8
    for (int i = 0; i < 32; ++i) {
        const int kk = 2 * i + (lane >> 5);
        float v = 0.f;
        if (c < nv) v = W[(size_t)(k0 + kk) * ldw + src0 + c];
        if (rs) v *= rs[k0 + kk];
        scr[kk * 33 + c] = v;
    }
    LDS_WAIT(); asm volatile("" ::: "memory");
    const int c8 = lane & 7;
#pragma unroll
    for (int j = 0; j < 4; ++j) {
        const int n = (lane >> 3) + 8 * j; const LAS float* s = scr + (8 * c8) * 33 + n;
        u32x4 o; o.x = cvt_pk(s[0 * 33], s[1 * 33]); o.y = cvt_pk(s[2 * 33], s[3 * 33]); o.z = cvt_pk(s[4 * 33], s[5 * 33]); o.w = cvt_pk(s[6 * 33], s[7 * 33]);
        *(u32x4*)(WT + (size_t)(n0 + n) * K + k0 + 8 * c8) = o;
    }
    LDS_WAIT(); asm volatile("" ::: "memory");
}

__device__ __forceinline__ void phase0(const Params& P, LAS unsigned char* lds, int tid, int G) {
    const int wave = tid >> 6, lane = tid & 63;
    const int gw = blockIdx.x * 8 + wave, NGW = G * 8;
    LAS float* scr = (LAS float*)(lds + wave * 16384);
    unsigned char* ws = P.ws;
    constexpr int I_W1 = 16 * 168, I_W4 = 16 * 128, I_SQ = 16 * 32, I_PE = 4 * 32;
    constexpr int NIT = I_W1 + I_W4 + 4 * I_SQ + I_PE;
    for (int it = gw; it < NIT; it += NGW) {
        int r = it;
        if (r < I_W1) {
            const int kb = r / 168, nb = r % 168, n0 = nb * 32; int src, nv;
            if (n0 < 2048) { src = n0; nv = 32; } else if (n0 < 5120) { src = n0 + 1040; nv = 32; } else if (n0 == 5120) { src = 2048; nv = 16; } else { src = 0; nv = 0; }
            p0_item(P.w_in, 9232, src, nv, nullptr, (bf16_t*)(ws + WS_W1T), 1024, n0, kb * 64, scr, lane); continue;
        }
        r -= I_W1;
        if (r < I_W4) {
            const int kb = r / 128, nb = r % 128, n0 = nb * 32; const int src = (n0 < 1024) ? 2064 + n0 : n0 + 5136;
            p0_item(P.w_in, 9232, src, 32, nullptr, (bf16_t*)(ws + WS_W4T), 1024, n0, kb * 64, scr, lane); continue;
        }
        r -= I_W4;
        if (r < 4 * I_SQ) {
            const int which = r / I_SQ; r -= which * I_SQ; const int kb = r / 32, nb = r % 32;
            const float* W = which == 0 ? P.w_out_gla : which == 1 ? P.w_out_sb : which == 2 ? P.w_out : P.w_ple_gate;
            bf16_t* dst = (bf16_t*)(ws + (which == 0 ? WS_WG : which == 1 ? WS_WS : which == 2 ? WS_WO : WS_WPG));
            p0_item(W, 1024, nb * 32, 32, which == 3 ? P.g_ple : nullptr, dst, 1024, nb * 32, kb * 64, scr, lane); continue;
        }
        r -= 4 * I_SQ;
        { const int kb = r / 32, nb = r % 32; p0_item(P.w_ple, 1024, nb * 32, 32, nullptr, (bf16_t*)(ws + WS_WPE), 256, nb * 32, kb * 64, scr, lane); }
    }
    bf16_t* H = (bf16_t*)(ws + WS_H);
    for (int m = gw; m < NTOK; m += NGW) {
        const f32x4* xr = (const f32x4*)(P.x + (size_t)m * DM) + lane; f32x4 v[4]; float s2 = 0.f;
#pragma unroll
        for (int j = 0; j < 4; ++j) { v[j] = xr[64 * j]; s2 += (v[j].x * v[j].x + v[j].y * v[j].y) + (v[j].z * v[j].z + v[j].w * v[j].w); }
        const float rstd = rsqrtf(wave_sum(s2) * (1.f / DM) + EPS);
        unsigned long long* o8 = (unsigned long long*)(H + (size_t)m * DM) + lane;
#pragma unroll
        for (int j = 0; j < 4; ++j) { const f32x4 g4 = ((const f32x4*)P.g_mix)[64 * j + lane]; const f32x4 o = v[j] * rstd * g4;
            o8[64 * j] = (unsigned long long)cvt_pk(o.x, o.y) | ((unsigned long long)cvt_pk(o.z, o.w) << 32); }
    }
    u32x4* PB = (u32x4*)(ws + WS_PB);
    for (int i = blockIdx.x * 512 + tid; i < NTOK * 256 / 8; i += G * 512) {
        const f32x4 a = ((const f32x4*)P.p)[2 * i], b = ((const f32x4*)P.p)[2 * i + 1];
        u32x4 o; o.x = cvt_pk(a.x, a.y); o.y = cvt_pk(a.z, a.w); o.z = cvt_pk(b.x, b.y); o.w = cvt_pk(b.z, b.w); PB[i] = o;
    }
}

typedef f32x4 AccT[2][2][4][2];
struct EpiZ1 {
    static constexpr bool PERM = true, AFTER_DRAIN = false;
    bf16_t* Z; float* LR;
    __device__ __forceinline__ void operator()(const AccT& acc, const pg8::Unit& u, int wr, int wc, int fr, int fq) const {
        const int row0 = u.pm * 256 + wr * 64 + fr;
        if (u.pn < 20) {
            const int col0 = u.pn * 256 + wc * 32 + 8 * fq;
#pragma unroll
            for (int ai = 0; ai < 2; ++ai)
#pragma unroll
                for (int m = 0; m < 4; ++m) { bf16_t* rowp = Z + (size_t)(row0 + ai * 128 + m * 16) * LDZ + col0;
#pragma unroll
                    for (int bj = 0; bj < 2; ++bj) { const f32x4 v0 = acc[ai][bj][m][0], v1 = acc[ai][bj][m][1];
                        u32x4 w; w.x = cvt_pk(v0[0], v0[1]); w.y = cvt_pk(v0[2], v0[3]); w.z = cvt_pk(v1[0], v1[1]); w.w = cvt_pk(v1[2], v1[3]);
                        *(u32x4*)(rowp + bj * 128) = w; } }
        } else if (wc == 0 && fq < 2) {
#pragma unroll
            for (int ai = 0; ai < 2; ++ai)
#pragma unroll
                for (int m = 0; m < 4; ++m) { float* lp = LR + (size_t)(row0 + ai * 128 + m * 16) * 16 + 8 * fq;
                    *(f32x4*)lp = acc[ai][0][m][0]; *(f32x4*)(lp + 4) = acc[ai][0][m][1]; }
        }
    }
};
struct EpiGates {
    static constexpr bool PERM = true, AFTER_DRAIN = false;
    bf16_t* Z; const float* SSA; const float* ggla; bf16_t* SG; bf16_t* SGX;
    __device__ __forceinline__ void operator()(const AccT& acc, const pg8::Unit& u, int wr, int wc, int fr, int fq) const {
        const int row0 = u.pm * 256 + wr * 64 + fr, cl = wc * 32 + 8 * fq;
        const int grp = u.pn >> 2;
        const int zc = (grp == 0 ? ZC_OA : grp == 1 ? ZC_OB : grp == 2 ? 0 : ZC_VB) + (u.pn & 3) * 256 + cl;
        f32x4 gv[2][2];
        if (grp == 0) {
#pragma unroll
            for (int bj = 0; bj < 2; ++bj) { const int c = (u.pn & 3) * 256 + bj * 128 + cl; gv[bj][0] = *(const f32x4*)(ggla + c); gv[bj][1] = *(const f32x4*)(ggla + c + 4); }
        }
#pragma unroll
        for (int ai = 0; ai < 2; ++ai)
#pragma unroll
        for (int mp = 0; mp < 2; ++mp) {
            u32x4 ov[2][2]; float rs[2];
            if (grp < 2) {
#pragma unroll
                for (int m = 2 * mp; m < 2 * mp + 2; ++m)
#pragma unroll
                    for (int bj = 0; bj < 2; ++bj) ov[m & 1][bj] = *(const u32x4*)(Z + (size_t)(row0 + ai * 128 + m * 16) * LDZ + zc + bj * 128);
            }
#pragma unroll
            for (int m = 2 * mp; m < 2 * mp + 2; ++m) { rs[m & 1] = 1.f;
                if (grp == 0) { const f32x4* sp = (const f32x4*)(SSA + (size_t)(row0 + ai * 128 + m * 16) * 64 + u.pn * 16); const f32x4 a = sp[0], b = sp[1], c = sp[2], d = sp[3];
                    const float s = ((a.x + a.y) + (a.z + a.w)) + ((b.x + b.y) + (b.z + b.w)) + ((c.x + c.y) + (c.z + c.w)) + ((d.x + d.y) + (d.z + d.w));
                    rs[m & 1] = rsqrtf(s * (1.f / 256.f) + EPS); } }
#pragma unroll
            for (int m = 2 * mp; m < 2 * mp + 2; ++m) {
                bf16_t* rowp = Z + (size_t)(row0 + ai * 128 + m * 16) * LDZ + zc;
#pragma unroll
                for (int bj = 0; bj < 2; ++bj) {
                    const f32x4 v0 = acc[ai][bj][m][0], v1 = acc[ai][bj][m][1];
                    float a[8] = {v0[0], v0[1], v0[2], v0[3], v1[0], v1[1], v1[2], v1[3]}; float o[8];
                    if (grp < 2) {
                        const u32x4 w_ = ov[m & 1][bj];
                        const float ovf[8] = {bflo(w_.x), bfhi(w_.x), bflo(w_.y), bfhi(w_.y), bflo(w_.z), bfhi(w_.z), bflo(w_.w), bfhi(w_.w)};
                        if (grp == 0) { const float gg[8] = {gv[bj][0].x, gv[bj][0].y, gv[bj][0].z, gv[bj][0].w, gv[bj][1].x, gv[bj][1].y, gv[bj][1].z, gv[bj][1].w};
#pragma unroll
                            for (int e = 0; e < 8; ++e) o[e] = ovf[e] * rs[m & 1] * gg[e] * siluf_(a[e]);
                        } else {
#pragma unroll
                            for (int e = 0; e < 8; ++e) o[e] = ovf[e] * siluf_(a[e]);
                        }
                    } else {
#pragma unroll
                        for (int e = 0; e < 8; ++e) o[e] = sigmoidf_(a[e]);
                    }
                    u32x4 w; w.x = cvt_pk(o[0], o[1]); w.y = cvt_pk(o[2], o[3]); w.z = cvt_pk(o[4], o[5]); w.w = cvt_pk(o[6], o[7]);
                    *(u32x4*)(rowp + bj * 128) = w;
                }
            }
        }
    }
};
struct EpiMerge {
    static constexpr bool PERM = true, AFTER_DRAIN = false;
    bf16_t* MG; const bf16_t* SG;
    __device__ __forceinline__ void operator()(const AccT& acc, const pg8::Unit& u, int wr, int wc, int fr, int fq) const {
        const int row0 = u.pm * 256 + wr * 64 + fr, cl = u.pn * 256 + wc * 32 + 8 * fq;
#pragma unroll
        for (int ai = 0; ai < 2; ++ai)
#pragma unroll
        for (int mp = 0; mp < 2; ++mp) {
            u32x4 sv[2][2], tv[2][2];
#pragma unroll
            for (int m = 2 * mp; m < 2 * mp + 2; ++m)
#pragma unroll
                for (int bj = 0; bj < 2; ++bj) { const size_t r = (size_t)(row0 + ai * 128 + m * 16); const int c = cl + bj * 128;
                    sv[m & 1][bj] = *(const u32x4*)(SG + r * LDZ + (u.sel ? ZC_VB : 0) + c);
                    if (u.sel) tv[m & 1][bj] = *(const u32x4*)(MG + r * LDZ + c); }
#pragma unroll
            for (int m = 2 * mp; m < 2 * mp + 2; ++m)
#pragma unroll
                for (int bj = 0; bj < 2; ++bj) {
                    const size_t r = (size_t)(row0 + ai * 128 + m * 16); const int c = cl + bj * 128;
                    const f32x4 v0 = acc[ai][bj][m][0], v1 = acc[ai][bj][m][1];
                    const float a[8] = {v0[0], v0[1], v0[2], v0[3], v1[0], v1[1], v1[2], v1[3]};
                    const u32x4 s_ = sv[m & 1][bj];
                    const float sg[8] = {bflo(s_.x), bfhi(s_.x), bflo(s_.y), bfhi(s_.y), bflo(s_.z), bfhi(s_.z), bflo(s_.w), bfhi(s_.w)};
                    float o[8];
                    if (u.sel) { const u32x4 t_ = tv[m & 1][bj];
                        const float tt[8] = {bflo(t_.x), bfhi(t_.x), bflo(t_.y), bfhi(t_.y), bflo(t_.z), bfhi(t_.z), bflo(t_.w), bfhi(t_.w)};
#pragma unroll
                        for (int e = 0; e < 8; ++e) o[e] = tt[e] + sg[e] * a[e];
                    } else {
#pragma unroll
                        for (int e = 0; e < 8; ++e) o[e] = sg[e] * a[e];
                    }
                    u32x4 w; w.x = cvt_pk(o[0], o[1]); w.y = cvt_pk(o[2], o[3]); w.z = cvt_pk(o[4], o[5]); w.w = cvt_pk(o[6], o[7]);
                    *(u32x4*)(MG + r * LDZ + c) = w;
                }
        }
    }
};
struct EpiX1 {
    static constexpr bool PERM = false, AFTER_DRAIN = false;
    const float* X; bf16_t* ZR; float* SS;
    __device__ __forceinline__ void operator()(const AccT& acc, const pg8::Unit& u, int wr, int wc, int fr, int fq) const {
        const int row0 = u.pm * 256 + wr * 64 + fr, cl = u.pn * 256 + wc * 32 + 4 * fq;
#pragma unroll
        for (int ai = 0; ai < 2; ++ai)
#pragma unroll
        for (int mp = 0; mp < 2; ++mp) {
            f32x4 xv[2][2][2];
#pragma unroll
            for (int m = 2 * mp; m < 2 * mp + 2; ++m)
#pragma unroll
                for (int bj = 0; bj < 2; ++bj)
#pragma unroll
                    for (int n = 0; n < 2; ++n) xv[m & 1][bj][n] = *(const f32x4*)(X + (size_t)(row0 + ai * 128 + m * 16) * 1024 + cl + bj * 128 + n * 16);
#pragma unroll
            for (int m = 2 * mp; m < 2 * mp + 2; ++m) {
                const int r = row0 + ai * 128 + m * 16; float ss = 0.f;
#pragma unroll
                for (int bj = 0; bj < 2; ++bj)
#pragma unroll
                    for (int n = 0; n < 2; ++n) {
                        const int c = cl + bj * 128 + n * 16;
                        const f32x4 v = xv[m & 1][bj][n] + acc[ai][bj][m][n];
                        *(f32x4*)((float*)(ZR + (size_t)r * LDZ + 2048) + c) = v;
                        u32x2 w; w.x = cvt_pk(v.x, v.y); w.y = cvt_pk(v.z, v.w); *(u32x2*)(ZR + (size_t)r * LDZ + c) = w;
                        ss += (v.x * v.x + v.y * v.y) + (v.z * v.z + v.w * v.w);
                    }
                ss += __shfl_xor(ss, 16); ss += __shfl_xor(ss, 32);
                if (fq == 0) SS[(size_t)r * 16 + u.pn * 4 + wc] = ss;
            }
        }
    }
};
struct EpiPE {
    static constexpr bool PERM = false, AFTER_DRAIN = false;
    bf16_t* PE;
    __device__ __forceinline__ void operator()(const AccT& acc, const pg8::Unit& u, int wr, int wc, int fr, int fq) const {
        const int row0 = u.pm * 256 + wr * 64 + fr, cl = u.pn * 256 + wc * 32 + 4 * fq;
#pragma unroll
        for (int ai = 0; ai < 2; ++ai)
#pragma unroll
            for (int m = 0; m < 4; ++m) {
                const int r = row0 + ai * 128 + m * 16;
#pragma unroll
                for (int bj = 0; bj < 2; ++bj)
#pragma unroll
                    for (int n = 0; n < 2; ++n) { const f32x4 v = acc[ai][bj][m][n]; u32x2 w; w.x = cvt_pk(v.x, v.y); w.y = cvt_pk(v.z, v.w);
                        *(u32x2*)(PE + (size_t)r * LDZ + ZC_VB + cl + bj * 128 + n * 16) = w; }
            }
    }
};
struct EpiX2 {
    static constexpr bool PERM = false, AFTER_DRAIN = false;
    bf16_t* ZR; const float* SS1; float* SS2;
    __device__ __forceinline__ void operator()(const AccT& acc, const pg8::Unit& u, int wr, int wc, int fr, int fq) const {
        const int row0 = u.pm * 256 + wr * 64 + fr, cl = u.pn * 256 + wc * 32 + 4 * fq;
#pragma unroll
        for (int ai = 0; ai < 2; ++ai)
#pragma unroll
            for (int m = 0; m < 4; ++m) {
                const int r = row0 + ai * 128 + m * 16;
                const f32x4* sp = (const f32x4*)(SS1 + (size_t)r * 16); const f32x4 a = sp[0], b = sp[1], c4 = sp[2], d = sp[3];
                const float s = ((a.x + a.y) + (a.z + a.w)) + ((b.x + b.y) + (b.z + b.w)) + ((c4.x + c4.y) + (c4.z + c4.w)) + ((d.x + d.y) + (d.z + d.w));
                const float rstd = rsqrtf(s * (1.f / 1024.f) + EPS);
                float ss = 0.f;
#pragma unroll
                for (int bj = 0; bj < 2; ++bj)
#pragma unroll
                    for (int n = 0; n < 2; ++n) {
                        const int c = cl + bj * 128 + n * 16;
                        float* xp = (float*)(ZR + (size_t)r * LDZ + 2048) + c;
                        const f32x4 x1 = *(const f32x4*)xp; const u32x2 pw = *(const u32x2*)(ZR + (size_t)r * LDZ + ZC_VB + c);
                        const f32x4 g = acc[ai][bj][m][n] * rstd;
                        f32x4 v;
                        v.x = x1.x + sigmoidf_(g.x) * bflo(pw.x); v.y = x1.y + sigmoidf_(g.y) * bfhi(pw.x);
                        v.z = x1.z + sigmoidf_(g.z) * bflo(pw.y); v.w = x1.w + sigmoidf_(g.w) * bfhi(pw.y);
                        *(f32x4*)xp = v;
                        ss += (v.x * v.x + v.y * v.y) + (v.z * v.z + v.w * v.w);
                    }
                ss += __shfl_xor(ss, 16); ss += __shfl_xor(ss, 32);
                if (fq == 0) SS2[(size_t)r * 16 + u.pn * 4 + wc] = ss;
            }
    }
};
struct PairOrder {
    pg8::StaticOrder base;
    __device__ void init(int M, int N, int G, int c) { base.init(M, N, G, c); }
    __device__ bool next(int i, pg8::Unit& u) const { if (!base.next(i >> 1, u)) return false; u.sel = i & 1; return true; }
    __device__ __forceinline__ void a_ready(const pg8::Unit&) const {}
    __device__ __forceinline__ void done(const pg8::Unit&) const {}
};

__device__ __forceinline__ int qperm(int dl) { return 8 * ((dl & 15) >> 2) + (dl & 3) + 4 * (dl >> 4); }
__device__ __forceinline__ void gla_prep_unit(const Params& P, LAS unsigned char* lds, int id, int tid) {
    const int b = id >> 9, c = (id >> 2) & 127, h = id & 3;
    const size_t tok0 = (size_t)b * SEQ + (size_t)c * 64;
    bf16_t* Z = (bf16_t*)(P.ws + WS_Z1);
    const float* LR = (const float*)(P.ws + WS_LR);
    float* DEC = (float*)(P.ws + WS_DEC);
    bf16_t* ATT = (bf16_t*)(P.ws + WS_ATTN);
    LAS bf16_t* QD = (LAS bf16_t*)lds; LAS bf16_t* KD = QD + 64 * 136; LAS bf16_t* QI = KD + 64 * 136; LAS bf16_t* KI = QI + 64 * 136;
    LAS float* lrs = (LAS float*)(lds + 4 * 64 * 136 * 2);
    LAS float* gs = lrs + 1024;
    const int d = tid & 127, tq = tid >> 7;
    if (tid < 256) ((LAS f32x4*)lrs)[tid] = ((const f32x4*)(LR + tok0 * 16))[tid];
    float wa[16];
#pragma unroll
    for (int r = 0; r < 16; ++r) wa[r] = P.w_alpha[r * 512 + h * 128 + d];
    const float ba = P.b_alpha[h * 128 + d];
    float qv[16], kv[16];
#pragma unroll
    for (int i = 0; i < 16; ++i) { const size_t row = tok0 + tq * 16 + i;
        qv[i] = bf2f(Z[row * LDZ + ZC_QA + h * 128 + d]); kv[i] = bf2f(Z[row * LDZ + ZC_KA + h * 128 + d]); }
    __syncthreads();
    float bc[16]; float run = 0.f;
#pragma unroll
    for (int i = 0; i < 16; ++i) { const int t = tq * 16 + i; float pre = ba;
#pragma unroll
        for (int r = 0; r < 16; ++r) pre += lrs[t * 16 + r] * wa[r];
        run += logsigmoidf_(pre) * (1.f / 16.f); bc[i] = run; }
    gs[tq * 128 + d] = run;
    VM_WAIT();
    __syncthreads();
    float off = 0.f, blast = 0.f;
#pragma unroll
    for (int g = 0; g < 4; ++g) { const float v = gs[g * 128 + d]; if (g < tq) off += v; blast += v; }
    const float scale = 0.08838834764831845f;
    float ke[16];
    const int dperm = (d & ~31) + qperm(d & 31);
#pragma unroll
    for (int i = 0; i < 16; ++i) {
        const float bb = bc[i] + off; const float eb = fexp(bb), enb = fexp(-bb);
        const int t = tq * 16 + i;
        const float qs = qv[i] * scale;
        const bf16_t qd = f2bf(qs * eb);
        QD[t * 136 + d] = qd; QI[t * 136 + d] = f2bf(qs * enb); KD[t * 136 + d] = f2bf(kv[i] * enb); KI[t * 136 + d] = f2bf(kv[i] * eb);
        Z[(tok0 + t) * LDZ + ZC_QA + h * 128 + dperm] = qd;
        ke[i] = kv[i] * fexp(blast - bb);
    }
    { u32x4 w0, w1; w0.x = cvt_pk(ke[0], ke[1]); w0.y = cvt_pk(ke[2], ke[3]); w0.z = cvt_pk(ke[4], ke[5]); w0.w = cvt_pk(ke[6], ke[7]);
      w1.x = cvt_pk(ke[8], ke[9]); w1.y = cvt_pk(ke[10], ke[11]); w1.z = cvt_pk(ke[12], ke[13]); w1.w = cvt_pk(ke[14], ke[15]);
      bf16_t* kp = Z + (tok0 + (d >> 1)) * LDZ + ZC_KA + h * 128 + (d & 1) * 64 + tq * 16;
      *(u32x4*)kp = w0; *(u32x4*)(kp + 8) = w1; }
    if (tq == 0) DEC[(size_t)id * 128 + d] = fexp(blast);
    __syncthreads();
    const int wave = tid >> 6, lane = tid & 63, fr = lane & 15, fq = lane >> 4;
#pragma unroll
    for (int tt = 0; tt < 2; ++tt) {
        const int tile = 2 * wave + tt, si = tile >> 2, ti = tile & 3;
        f32x4 ap = {0.f, 0.f, 0.f, 0.f}, af = {0.f, 0.f, 0.f, 0.f};
#pragma unroll
        for (int kk = 0; kk < 4; ++kk) {
            const bf16x8 a1 = *(const LAS bf16x8*)(KD + (16 * si + fr) * 136 + 32 * kk + 8 * fq), b1 = *(const LAS bf16x8*)(QD + (16 * ti + fr) * 136 + 32 * kk + 8 * fq);
            const bf16x8 a2 = *(const LAS bf16x8*)(KI + (16 * si + fr) * 136 + 32 * kk + 8 * fq), b2 = *(const LAS bf16x8*)(QI + (16 * ti + fr) * 136 + 32 * kk + 8 * fq);
            ap = __builtin_amdgcn_mfma_f32_16x16x32_bf16(a1, b1, ap, 0, 0, 0);
            af = __builtin_amdgcn_mfma_f32_16x16x32_bf16(a2, b2, af, 0, 0, 0);
        }
        const int sb = 16 * si + 4 * fq, t = 16 * ti + fr;
        float v[4];
#pragma unroll
        for (int j = 0; j < 4; ++j) v[j] = (sb + j <= t) ? ap[j] : af[j];
        u32x2 w; w.x = cvt_pk(v[0], v[1]); w.y = cvt_pk(v[2], v[3]);
        *(u32x2*)(ATT + (size_t)id * 4096 + t * 64 + sb) = w;
    }
    __syncthreads();
}

__device__ __forceinline__ s16x4 lds_tr(LAS unsigned char* p) { return __builtin_bit_cast(s16x4, __builtin_amdgcn_ds_read_tr16_b64_v4i16((LAS s16x4*)p)); }
__device__ __forceinline__ bf16x8 cat8(s16x4 lo, s16x4 hi) { bf16x8 r; r[0] = lo[0]; r[1] = lo[1]; r[2] = lo[2]; r[3] = lo[3]; r[4] = hi[0]; r[5] = hi[1]; r[6] = hi[2]; r[7] = hi[3]; return r; }
__device__ __forceinline__ void sb_unit(const Params& P, LAS unsigned char* lds, int id, int tid) {
    const int b = id >> 8, hd = (id >> 5) & 7, qt = id & 31;
    const int wave = tid >> 6, lane = tid & 63, ql = lane & 31, hh = lane >> 5;
    const int q0 = qt * 256, qw = q0 + 32 * wave, t = qw + ql;
    LAS unsigned char* Ks = lds; LAS unsigned char* Vs = lds + 64 * 272; LAS int* flags = (LAS int*)(lds + 2 * 64 * 272);
    bf16_t* Zb = (bf16_t*)(P.ws + WS_Z1) + (size_t)b * SEQ * LDZ;
    bf16x8 qf[8];
#pragma unroll
    for (int kk = 0; kk < 8; ++kk) qf[kk] = *(const bf16x8*)(Zb + (size_t)t * LDZ + ZC_QB + hd * 128 + 16 * kk + 8 * hh);
    f32x16 oacc[4];
#pragma unroll
    for (int db = 0; db < 4; ++db)
#pragma unroll
        for (int i = 0; i < 16; ++i) oacc[db][i] = 0.f;
    float R = 0.f; int wdone = 0;
    __syncthreads();
    if (lane == 0) flags[wave] = 0;
    const int i16 = lane & 15, blk = (lane >> 4) & 1;
    const float c2 = 0.08838834764831845f * 1.4426950408889634f;
    u32x4 kst[2], vst[2];
    { const int key0 = 64 * (4 * qt + 3);
#pragma unroll
      for (int i = 0; i < 2; ++i) { const int ch = tid + 512 * i, row = ch >> 4, cc = ch & 15; const bf16_t* src = Zb + (size_t)(key0 + row) * LDZ + hd * 128 + cc * 8;
          kst[i] = *(const u32x4*)(src + ZC_KB); vst[i] = *(const u32x4*)(src + ZC_VB); } }
    for (int kt = 4 * qt + 3; kt >= 0; --kt) {
        __syncthreads();
        int alld = 1;
#pragma unroll
        for (int w = 0; w < 8; ++w) alld &= flags[w];
        if (alld) break;
        const int key0 = 64 * kt;
#pragma unroll
        for (int i = 0; i < 2; ++i) { const int ch = tid + 512 * i, row = ch >> 4, cc = ch & 15;
            *(LAS u32x4*)(Ks + row * 272 + cc * 16) = kst[i]; *(LAS u32x4*)(Vs + row * 272 + cc * 16) = vst[i]; }
        if (kt > 0) {
#pragma unroll
            for (int i = 0; i < 2; ++i) { const int ch = tid + 512 * i, row = ch >> 4, cc = ch & 15; const bf16_t* src = Zb + (size_t)(key0 - 64 + row) * LDZ + hd * 128 + cc * 8;
                kst[i] = *(const u32x4*)(src + ZC_KB); vst[i] = *(const u32x4*)(src + ZC_VB); } }
        __syncthreads();
        if (!wdone && key0 <= qw + 30) {
#pragma unroll
            for (int kb = 1; kb >= 0; --kb) {
                const int kbase = key0 + 32 * kb;
                if (kbase > qw + 30) continue;
                f32x16 sacc;
#pragma unroll
                for (int i = 0; i < 16; ++i) sacc[i] = 0.f;
#pragma unroll
                for (int kk = 0; kk < 8; ++kk) { const bf16x8 a = *(const LAS bf16x8*)(Ks + (32 * kb + ql) * 272 + (16 * kk + 8 * hh) * 2);
                    sacc = __builtin_amdgcn_mfma_f32_32x32x16_bf16(a, qf[kk], sacc, 0, 0, 0); }
                float L[16], zl[16];
#pragma unroll
                for (int i = 0; i < 16; ++i) { const int key = kbase + 8 * (i >> 2) + 4 * hh + (i & 3); const bool valid = key < t;
                    const float z2 = sacc[i] * c2; const float sp = fmaxf(z2, 0.f) + flog2(1.0f + fexp2(-fabsf(z2)));
                    const float l = valid ? -sp : 0.f; L[i] = l; zl[i] = valid ? (z2 + l) : -1.0e30f; }
                float Pg[4], Qg[4], Tg[4];
#pragma unroll
                for (int g = 0; g < 4; ++g) { Pg[g] = (L[4 * g] + L[4 * g + 1]) + (L[4 * g + 2] + L[4 * g + 3]); Qg[g] = __shfl_xor(Pg[g], 32); }
                Tg[3] = 0.f; Tg[2] = Pg[3] + Qg[3]; Tg[1] = Tg[2] + (Pg[2] + Qg[2]); Tg[0] = Tg[1] + (Pg[1] + Qg[1]);
                const float total = Tg[0] + (Pg[0] + Qg[0]);
                float w[16];
#pragma unroll
                for (int g = 0; g < 4; ++g) { float e = R + Tg[g] + (hh == 0 ? Qg[g] : 0.f);
                    w[4 * g + 3] = fexp2(zl[4 * g + 3] + e); e += L[4 * g + 3];
                    w[4 * g + 2] = fexp2(zl[4 * g + 2] + e); e += L[4 * g + 2];
                    w[4 * g + 1] = fexp2(zl[4 * g + 1] + e); e += L[4 * g + 1];
                    w[4 * g + 0] = fexp2(zl[4 * g + 0] + e); }
                R += total;
                bf16x8 pa[2];
#pragma unroll
                for (int gp = 0; gp < 2; ++gp) { u32x4 pw; pw.x = cvt_pk(w[8 * gp], w[8 * gp + 1]); pw.y = cvt_pk(w[8 * gp + 2], w[8 * gp + 3]); pw.z = cvt_pk(w[8 * gp + 4], w[8 * gp + 5]); pw.w = cvt_pk(w[8 * gp + 6], w[8 * gp + 7]);
                    pa[gp] = __builtin_bit_cast(bf16x8, pw); }
#pragma unroll
                for (int gp = 0; gp < 2; ++gp)
#pragma unroll
                    for (int db = 0; db < 4; ++db) {
                        LAS unsigned char* vp = Vs + (32 * kb + 16 * gp + 4 * hh + (i16 >> 2)) * 272 + (32 * db + 16 * blk + 4 * (i16 & 3)) * 2;
                        const s16x4 lo = lds_tr(vp), hi = lds_tr(vp + 8 * 272);
                        oacc[db] = __builtin_amdgcn_mfma_f32_32x32x16_bf16(pa[gp], cat8(lo, hi), oacc[db], 0, 0, 0);
                    }
            }
            wdone = __all(R < -151.0f) ? 1 : 0;
        }
        if (lane == 0) flags[wave] = wdone;
    }
#pragma unroll
    for (int db = 0; db < 4; ++db)
#pragma unroll
        for (int i = 0; i < 16; ++i) { const int qr = qw + (i & 3) + 8 * (i >> 2) + 4 * hh;
            Zb[(size_t)qr * LDZ + ZC_OB + hd * 128 + 32 * db + ql] = f2bf(oacc[db][i]); }
}

__device__ __forceinline__ void gla_scan_unit(const Params& P, LAS unsigned char* lds, int unit, int wave, int lane) {
    const int b = unit >> 6, h = (unit >> 4) & 3, sl = unit & 15;
    const int fr = lane & 15, fq = lane >> 4, tw = wave;
    LAS unsigned char* vl = lds + wave * 2048;
    bf16_t* Zb = (bf16_t*)(P.ws + WS_Z1) + (size_t)b * SEQ * LDZ;
    const float* DEC = (const float*)(P.ws + WS_DEC);
    const bf16_t* ATT = (const bf16_t*)(P.ws + WS_ATTN);
    float* SSA = (float*)(P.ws + WS_SSA);
    f32x4 S[8];
#pragma unroll
    for (int mt = 0; mt < 8; ++mt) S[mt] = (f32x4){0.f, 0.f, 0.f, 0.f};
    u32x4 vr0, vr1; bf16x8 aa[2][2], qa[2][4], ka[8][2]; f32x4 dcr[8];
#define SCAN_LOAD(cc) do { const int tk = (cc) * 64; const size_t idn = ((size_t)b * 128 + (cc)) * 4 + h; \
        const u32x4* vp_ = (const u32x4*)(Zb + (size_t)(tk + lane) * LDZ + ZC_VA + h * 256 + sl * 16); vr0 = vp_[0]; vr1 = vp_[1]; \
        _Pragma("unroll") for (int mt = 0; mt < 8; ++mt) dcr[mt] = *(const f32x4*)(DEC + idn * 128 + 16 * mt + 4 * fq); \
        _Pragma("unroll") for (int tt = 0; tt < 2; ++tt) { _Pragma("unroll") for (int ks = 0; ks < 2; ++ks) aa[tt][ks] = *(const bf16x8*)(ATT + idn * 4096 + (32 * tw + 16 * tt + fr) * 64 + 32 * ks + 8 * fq); \
        _Pragma("unroll") for (int kq = 0; kq < 4; ++kq) qa[tt][kq] = *(const bf16x8*)(Zb + (size_t)(tk + 32 * tw + 16 * tt + fr) * LDZ + ZC_QA + h * 128 + 32 * kq + 8 * fq); } \
        _Pragma("unroll") for (int mt = 0; mt < 8; ++mt) _Pragma("unroll") for (int ks = 0; ks < 2; ++ks) { const int dk = 16 * mt + fr; \
            ka[mt][ks] = *(const bf16x8*)(Zb + (size_t)(tk + (dk >> 1)) * LDZ + ZC_KA + h * 128 + (dk & 1) * 64 + 32 * ks + 8 * fq); } } while (0)
    SCAN_LOAD(0);
    for (int c = 0; c < 128; ++c) {
        const size_t id = ((size_t)b * 128 + c) * 4 + h;
        if (wave == 0 && lane == 0) *(volatile LAS int*)(lds + 16384) = c;
#if SCAN_DIRECT_V == 1
        bf16x8 bv[2];
#pragma unroll
        for (int ks = 0; ks < 2; ++ks)
#pragma unroll
            for (int j = 0; j < 8; ++j) bv[ks][j] = (short)Zb[(size_t)(c * 64 + 32 * ks + 8 * fq + j) * LDZ + ZC_VA + h * 256 + sl * 16 + fr];
#else
        *(LAS u32x4*)(vl + lane * 32) = vr0; *(LAS u32x4*)(vl + lane * 32 + 16) = vr1;
        asm volatile("s_waitcnt lgkmcnt(0)" ::: "memory");
        bf16x8 bv[2];
#pragma unroll
#if SCAN_DIRECT_V == 2
        for (int ks = 0; ks < 2; ++ks)
#pragma unroll
            for (int j = 0; j < 8; ++j) bv[ks][j] = *(const LAS short*)(vl + (32 * ks + 8 * fq + j) * 32 + fr * 2);
#else
        for (int ks = 0; ks < 2; ++ks) { LAS unsigned char* vp = vl + (32 * ks + 8 * fq + (fr >> 2)) * 32 + (fr & 3) * 8;
            const s16x4 lo = lds_tr(vp), hi = lds_tr(vp + 4 * 32); bv[ks] = cat8(lo, hi); }
#endif
        asm volatile("s_waitcnt lgkmcnt(0)" ::: "memory");
#endif
        f32x4 o[2]; bf16x8 bs[4];
#pragma unroll
        for (int kq = 0; kq < 4; ++kq) { u32x4 sw; sw.x = cvt_pk(S[2 * kq][0], S[2 * kq][1]); sw.y = cvt_pk(S[2 * kq][2], S[2 * kq][3]); sw.z = cvt_pk(S[2 * kq + 1][0], S[2 * kq + 1][1]); sw.w = cvt_pk(S[2 * kq + 1][2], S[2 * kq + 1][3]); bs[kq] = __builtin_bit_cast(bf16x8, sw); }
#pragma unroll
        for (int tt = 0; tt < 2; ++tt) { o[tt] = (f32x4){0.f, 0.f, 0.f, 0.f};
            o[tt] = __builtin_amdgcn_mfma_f32_16x16x32_bf16(aa[tt][0], bv[0], o[tt], 0, 0, 0);
            o[tt] = __builtin_amdgcn_mfma_f32_16x16x32_bf16(aa[tt][1], bv[1], o[tt], 0, 0, 0);
#pragma unroll
            for (int kq = 0; kq < 4; ++kq) o[tt] = __builtin_amdgcn_mfma_f32_16x16x32_bf16(qa[tt][kq], bs[kq], o[tt], 0, 0, 0); }
#pragma unroll
        for (int mt = 0; mt < 8; ++mt) {
            S[mt] = S[mt] * dcr[mt];
            S[mt] = __builtin_amdgcn_mfma_f32_16x16x32_bf16(ka[mt][0], bv[0], S[mt], 0, 0, 0);
            S[mt] = __builtin_amdgcn_mfma_f32_16x16x32_bf16(ka[mt][1], bv[1], S[mt], 0, 0, 0); }
        const int cn = (c + 1) & 127;
        SCAN_LOAD(cn);
#pragma unroll
        for (int tt = 0; tt < 2; ++tt)
#pragma unroll
        for (int j = 0; j < 4; ++j) {
            const size_t tok = (size_t)c * 64 + 32 * tw + 16 * tt + 4 * fq + j;
            Zb[tok * LDZ + ZC_OA + h * 256 + sl * 16 + fr] = f2bf(o[tt][j]);
            float q = o[tt][j] * o[tt][j];
            q += __shfl_xor(q, 1); q += __shfl_xor(q, 2); q += __shfl_xor(q, 4); q += __shfl_xor(q, 8);
            if (fr == 0) SSA[((size_t)b * SEQ + tok) * 64 + h * 16 + sl] = q;
        }
    }
#undef SCAN_LOAD
}


constexpr int SC_KT = 0, SC_QA = 16384, SC_AA = 32768, SC_V = 40960, SC_DEC = 43008, SC_SLOT = 44032, SC_BASE = 0;
__device__ __forceinline__ void gla_scan_unit2(const Params& P, LAS unsigned char* lds, int unit, int wave, int lane) {
    const int b = unit >> 6, h = (unit >> 4) & 3, sl = unit & 15;
    const int fr = lane & 15, fq = lane >> 4, tw = wave;
    bf16_t* Zb = (bf16_t*)(P.ws + WS_Z1) + (size_t)b * SEQ * LDZ;
    const float* DEC = (const float*)(P.ws + WS_DEC);
    const bf16_t* ATT = (const bf16_t*)(P.ws + WS_ATTN);
    float* SSA = (float*)(P.ws + WS_SSA);
    LAS unsigned char* ring = lds + SC_BASE;
    if (wave == 4) {
        u32x4 r[2][19];
#define LOADA(cc, R) do { const int tk = (cc) * 64; const size_t idn = ((size_t)b * 128 + (cc)) * 4 + h; \
            _Pragma("unroll") for (int i = 0; i < 16; ++i) { const int mt = i >> 1, ks = i & 1, dk = 16 * mt + fr; r[R][i] = *(const u32x4*)(Zb + (size_t)(tk + (dk >> 1)) * LDZ + ZC_KA + h * 128 + (dk & 1) * 64 + 32 * ks + 8 * fq); } \
            { const u32x4* vp_ = (const u32x4*)(Zb + (size_t)(tk + lane) * LDZ + ZC_VA + h * 256 + sl * 16); r[R][16] = vp_[0]; r[R][17] = vp_[1]; } \
            r[R][18] = *(const u32x4*)(DEC + idn * 128 + 4 * (lane & 31)); } while (0)
#define STOREA(slot, R) do { LAS unsigned char* s_ = ring + (slot) * SC_SLOT; \
            _Pragma("unroll") for (int i = 0; i < 16; ++i) *(LAS u32x4*)(s_ + SC_KT + i * 1024 + lane * 16) = r[R][i]; \
            *(LAS u32x4*)(s_ + SC_V + lane * 32) = r[R][16]; *(LAS u32x4*)(s_ + SC_V + lane * 32 + 16) = r[R][17]; \
            if (lane < 32) *(LAS u32x4*)(s_ + SC_DEC + lane * 16) = r[R][18]; } while (0)
        LOADA(0, 0); STOREA(0, 0); LOADA(1, 0); LOADA(2, 1);
        __syncthreads();
        for (int c = 0; c < 128; c += 2) { STOREA(1, 0); LOADA((c + 3) & 127, 0); __syncthreads();
                                            STOREA(0, 1); LOADA((c + 4) & 127, 1); __syncthreads(); }
#undef LOADA
#undef STOREA
        return;
    }
    if (wave == 5) {
        u32x4 r[2][24];
#define LOADB(cc, R) do { const int tk = (cc) * 64; const size_t idn = ((size_t)b * 128 + (cc)) * 4 + h; \
            _Pragma("unroll") for (int i = 0; i < 16; ++i) { const int t4 = i >> 2, kq = i & 3; r[R][i] = *(const u32x4*)(Zb + (size_t)(tk + 16 * t4 + fr) * LDZ + ZC_QA + h * 128 + 32 * kq + 8 * fq); } \
            _Pragma("unroll") for (int i = 0; i < 8; ++i) { const int t4 = i >> 1, ks = i & 1; r[R][16 + i] = *(const u32x4*)(ATT + idn * 4096 + (16 * t4 + fr) * 64 + 32 * ks + 8 * fq); } } while (0)
#define STOREB(slot, R) do { LAS unsigned char* s_ = ring + (slot) * SC_SLOT; \
            _Pragma("unroll") for (int i = 0; i < 16; ++i) *(LAS u32x4*)(s_ + SC_QA + i * 1024 + lane * 16) = r[R][i]; \
            _Pragma("unroll") for (int i = 0; i < 8; ++i) *(LAS u32x4*)(s_ + SC_AA + i * 1024 + lane * 16) = r[R][16 + i]; } while (0)
        LOADB(0, 0); STOREB(0, 0); LOADB(1, 0); LOADB(2, 1);
        __syncthreads();
        for (int c = 0; c < 128; c += 2) { STOREB(1, 0); LOADB((c + 3) & 127, 0); __syncthreads();
                                            STOREB(0, 1); LOADB((c + 4) & 127, 1); __syncthreads(); }
#undef LOADB
#undef STOREB
        return;
    }
    if (wave >= 2) {
        __syncthreads();
        for (int c = 0; c < 128; ++c) __syncthreads();
        return;
    }
    f32x4 S[8];
#pragma unroll
    for (int mt = 0; mt < 8; ++mt) S[mt] = (f32x4){0.f, 0.f, 0.f, 0.f};
    __syncthreads();
    for (int c = 0; c < 128; ++c) {
        const LAS unsigned char* s_ = ring + (c & 1) * SC_SLOT;
        bf16x8 bv[2];
#pragma unroll
        for (int ks = 0; ks < 2; ++ks)
#pragma unroll
            for (int j = 0; j < 8; ++j) bv[ks][j] = *(const LAS short*)(s_ + SC_V + (32 * ks + 8 * fq + j) * 32 + fr * 2);
        f32x4 o[2]; bf16x8 bs[4];
#pragma unroll
        for (int kq = 0; kq < 4; ++kq) { u32x4 sw; sw.x = cvt_pk(S[2 * kq][0], S[2 * kq][1]); sw.y = cvt_pk(S[2 * kq][2], S[2 * kq][3]); sw.z = cvt_pk(S[2 * kq + 1][0], S[2 * kq + 1][1]); sw.w = cvt_pk(S[2 * kq + 1][2], S[2 * kq + 1][3]); bs[kq] = __builtin_bit_cast(bf16x8, sw); }
#pragma unroll
        for (int tt = 0; tt < 2; ++tt) { const int t4 = 2 * tw + tt; o[tt] = (f32x4){0.f, 0.f, 0.f, 0.f};
#pragma unroll
            for (int ks = 0; ks < 2; ++ks) { const bf16x8 a = *(const LAS bf16x8*)(s_ + SC_AA + (t4 * 2 + ks) * 1024 + lane * 16); o[tt] = __builtin_amdgcn_mfma_f32_16x16x32_bf16(a, bv[ks], o[tt], 0, 0, 0); }
#pragma unroll
            for (int kq = 0; kq < 4; ++kq) { const bf16x8 a = *(const LAS bf16x8*)(s_ + SC_QA + (t4 * 4 + kq) * 1024 + lane * 16); o[tt] = __builtin_amdgcn_mfma_f32_16x16x32_bf16(a, bs[kq], o[tt], 0, 0, 0); } }
#pragma unroll
        for (int mt = 0; mt < 8; ++mt) { const f32x4 dc = *(const LAS f32x4*)(s_ + SC_DEC + (16 * mt + 4 * fq) * 4);
            S[mt] = S[mt] * dc;
#pragma unroll
            for (int ks = 0; ks < 2; ++ks) { const bf16x8 a = *(const LAS bf16x8*)(s_ + SC_KT + (mt * 2 + ks) * 1024 + lane * 16); S[mt] = __builtin_amdgcn_mfma_f32_16x16x32_bf16(a, bv[ks], S[mt], 0, 0, 0); } }
#pragma unroll
        for (int tt = 0; tt < 2; ++tt)
#pragma unroll
        for (int j = 0; j < 4; ++j) {
            const size_t tok = (size_t)c * 64 + 32 * tw + 16 * tt + 4 * fq + j;
            Zb[tok * LDZ + ZC_OA + h * 256 + sl * 16 + fr] = f2bf(o[tt][j]);
            float q = o[tt][j] * o[tt][j];
            q += __shfl_xor(q, 1); q += __shfl_xor(q, 2); q += __shfl_xor(q, 4); q += __shfl_xor(q, 8);
            if (fr == 0) SSA[((size_t)b * SEQ + tok) * 64 + h * 16 + sl] = q;
        }
        __syncthreads();
    }
}

__device__ __forceinline__ void gla_scan_prefetch(const Params& P, LAS unsigned char* lds, int unit, int lane) {
    const int b = unit >> 6, h = (unit >> 4) & 3, sl = unit & 15;
    const unsigned char* Zb = (const unsigned char*)((const bf16_t*)(P.ws + WS_Z1) + (size_t)b * SEQ * LDZ);
    const int L = sl * 64 + lane;
    float acc = 0.f;
    for (int pc = 0; pc < 128; pc += 2) {
        while (*(volatile LAS int*)(lds + 16384) + 10 < pc) __builtin_amdgcn_s_sleep(4);
#pragma unroll
        for (int k = 0; k < 2; ++k) { const int c = pc + k; const size_t id = ((size_t)b * 128 + c) * 4 + h; const unsigned char* p = nullptr;
            if (L < 128) p = Zb + ((size_t)c * 64 + (L >> 1)) * (LDZ * 2) + (ZC_KA + h * 128) * 2 + (L & 1) * 128;
            else if (L < 256) p = Zb + ((size_t)c * 64 + ((L - 128) >> 1)) * (LDZ * 2) + (ZC_QA + h * 128) * 2 + (L & 1) * 128;
            else if (L < 512) p = Zb + ((size_t)c * 64 + ((L - 256) >> 2)) * (LDZ * 2) + (ZC_VA + h * 256) * 2 + (L & 3) * 128;
            else if (L < 576) p = P.ws + WS_ATTN + id * 8192 + (size_t)(L - 512) * 128;
            else if (L < 580) p = P.ws + WS_DEC + id * 512 + (size_t)(L - 576) * 128;
            if (p) acc += *(const volatile float*)p; }
    }
    if (acc == 1.2345e-30f) *(volatile LAS float*)(lds + 16388) = acc;
}

__global__ void __launch_bounds__(512, 2) fwd_kernel(Params P) {
    extern __shared__ __attribute__((aligned(16))) unsigned char lds_raw[];
#if N_LAUNCHES == 1
    cg::grid_group grid = cg::this_grid();
#endif
    LAS unsigned char* lds = (LAS unsigned char*)lds_raw;
    volatile LAS unsigned* MISC = (volatile LAS unsigned*)(lds + 131072 + 320);
    if (threadIdx.x < 32) MISC[threadIdx.x] = 0u;
    __syncthreads();
#if !USE_CG_SYNC
    XcdBarrier bar = xcd_barrier_post((unsigned*)P.ws + 4096, MISC + 8);
    if (P.ws == nullptr) grid.sync();
#endif
#if N_LAUNCHES != 1
#define GRID_SYNC() do { } while (0)
#elif USE_CG_SYNC
#define GRID_SYNC() do { asm volatile("s_waitcnt vmcnt(0)" ::: "memory"); grid.sync(); __builtin_amdgcn_fence(__ATOMIC_ACQUIRE, "agent"); asm volatile("s_waitcnt vmcnt(0)" ::: "memory"); } while (0)
#else
#if SYS_INV
#define GRID_SYNC() do { asm volatile("s_waitcnt vmcnt(0)\n\tbuffer_wbl2 sc0 sc1\n\ts_waitcnt vmcnt(0)" ::: "memory"); xcd_barrier(bar); asm volatile("buffer_inv sc0 sc1\n\ts_waitcnt vmcnt(0)" ::: "memory"); __syncthreads(); } while (0)
#else
#define GRID_SYNC() xcd_barrier(bar)
#endif
#endif
    const int G = gridDim.x;
    unsigned char* ws = P.ws;
    bf16_t* Z = (bf16_t*)(ws + WS_Z1);
    bf16_t* H = (bf16_t*)(ws + WS_H);

#if N_LAUNCHES == 1
#define IN(k) true
#if DIAG == 20
#define STAMP(k) do { if (blockIdx.x == 0 && threadIdx.x == 0) ((unsigned long long*)(P.ws + 500 * MiB + 8192))[k] = __builtin_amdgcn_s_memrealtime(); } while (0)
#else
#define STAMP(k) do { } while (0)
#endif
#else
#define IN(k) (P.ph_lo <= (k) && (k) < P.ph_hi)
#endif
#define BOTH(k) (IN(k) && IN((k) + 1))
    STAMP(0);
    if (IN(0)) {
#if DIAG == 4
    { const int tid = fresh_tid(); for (size_t i = (size_t)blockIdx.x * 512 + tid; i < (size_t)NTOK * 1024; i += (size_t)G * 512) P.out[i] = 0.f; }
#endif
    phase0(P, lds, fresh_tid(), G);
    }
    if (BOTH(0)) GRID_SYNC();
    STAMP(1);
    if (IN(1)) {
#if DIAG == 9
    { const int tid = fresh_tid(); const bf16_t* w0 = (const bf16_t*)(ws + WS_WG); const bf16_t* w1 = (const bf16_t*)(ws + WS_WS); const bf16_t* w2 = (const bf16_t*)(ws + WS_WO); const bf16_t* w3 = (const bf16_t*)(ws + WS_WPG); const bf16_t* w4 = (const bf16_t*)(ws + WS_WPE);
      const bf16_t* pb = (const bf16_t*)(ws + WS_PB);
      for (size_t i = (size_t)blockIdx.x * 512 + tid; i < (size_t)NTOK * 1024; i += (size_t)G * 512) { const size_t j = i & 0xFFFFF;
          P.out[i] = bf2f(((const bf16_t*)(ws + WS_W4T))[i & 0x3FFFFF]) + 2.f * bf2f(((const bf16_t*)(ws + WS_W1T))[i % (5376u * 1024u)]) + 3.f * bf2f(H[i]); }
      return; }
#endif
    {
        pg8::Gemm g{H, (const bf16_t*)(ws + WS_W1T), H, (const bf16_t*)(ws + WS_W1T), NTOK, 5376, 1024, 1024};
        pg8::StaticOrder S; S.init(NTOK, 5376, G, (int)blockIdx.x);
        EpiZ1 E{Z, (float*)(ws + WS_LR)};
        pg8::gemm_phase<EpiZ1, pg8::StaticOrder, true, true>(lds, g, S, E);
    }
    }
    if (BOTH(1)) GRID_SYNC();
    STAMP(2);
    if (IN(2)) {
#if DIAG == 2
    {
        const int tid = fresh_tid();
        for (size_t i = (size_t)blockIdx.x * 512 + tid; i < (size_t)NTOK * 1024; i += (size_t)G * 512) { const size_t r = i >> 10, c = i & 1023;
            P.out[i] = bf2f(Z[r * LDZ + c + 2048]) + ((const float*)(ws + WS_LR))[r * 16 + (c & 15)]; }
        return;
    }
#endif
#if DIAG == 14
    {
        const int tid = fresh_tid(); const size_t r0 = (size_t)blockIdx.x * 128 + (tid & 127); const int grp = tid >> 7;
        if (blockIdx.x == 0 && tid == 0) { *(unsigned*)(ws + 500 * MiB) = 0u; *((unsigned*)(ws + 500 * MiB) + 64) = 0u; }
        float ss = 0.f; for (int k = 0; k < 1024; ++k) { const float v = P.x[r0 * 1024 + k]; ss += v * v; }
        const float rstd = rsqrtf(ss / 1024.f + EPS);
        const int cols[12] = {7, 300, 777, 1500, 2100, 3000, 3500, 4100, 5000, 5121, 1023, 4607};
        int bad = 0;
#pragma unroll
        for (int j = 0; j < 3; ++j) { const int n = cols[grp * 3 + j]; const int col = n < 2048 ? n : (n < 5120 ? n + 1040 : 2048 + (n - 5120)); float s = 0.f;
            for (int k = 0; k < 1024; ++k) s += P.x[r0 * 1024 + k] * rstd * P.g_mix[k] * P.w_in[(size_t)k * 9232 + col];
            const float g = n < 5120 ? bf2f(Z[r0 * LDZ + n]) : ((const float*)(ws + WS_LR))[r0 * 16 + (n - 5120)];
            if (fabsf(s - g) > 0.05f) ++bad; }
        if (bad) { atomicAdd((unsigned*)(ws + 500 * MiB), (unsigned)bad); atomicMax((unsigned*)(ws + 500 * MiB) + 64, (unsigned)(r0 & 255) + 1u); }
        __threadfence(); __syncthreads();
    }
    GRID_SYNC();
    { const int tid = fresh_tid(); const float cst = (float)__hip_atomic_load((const unsigned*)(ws + 500 * MiB) + DIAG13_WHICH * 64, __ATOMIC_RELAXED, __HIP_MEMORY_SCOPE_AGENT);
      for (size_t i = (size_t)blockIdx.x * 512 + tid; i < (size_t)NTOK * 1024; i += (size_t)G * 512) P.out[i] = cst; }
    return;
#endif
#if DIAG == 15
    if (blockIdx.x == 0) {
        const int tid = fresh_tid(); const int bq = DIAG_B, hq = DIAG_H;
        float* EXP = (float*)(ws + 470 * MiB); float* ST = (float*)(ws + 480 * MiB); float* BB = ST + 128 * 256; float* AT = BB + 64 * 128;
        const float* LRp = (const float*)(ws + WS_LR); const float sc = 0.08838834764831845f;
        if (tid == 0) { *(unsigned*)(ws + 500 * MiB) = 0u; *((unsigned*)(ws + 500 * MiB) + 64) = 0u; }
        for (int i = tid; i < 128 * 256; i += 512) ST[i] = 0.f;
        __threadfence(); __syncthreads();
        for (int c = 0; c < 128; ++c) {
            const size_t tk = (size_t)bq * SEQ + (size_t)c * 64;
            if (tid < 128) { const int d = tid; float run = 0.f;
                for (int t = 0; t < 64; ++t) { float pre = P.b_alpha[hq * 128 + d]; for (int r = 0; r < 16; ++r) pre += LRp[(tk + t) * 16 + r] * P.w_alpha[r * 512 + hq * 128 + d];
                    run += (fminf(pre, 0.f) - log1pf(expf(-fabsf(pre)))) / 16.f; BB[t * 128 + d] = run; } }
            __threadfence(); __syncthreads();
            for (int i = tid; i < 64 * 64; i += 512) { const int t = i >> 6, s = i & 63; float a = 0.f;
                for (int d = 0; d < 128; ++d) a += bf2f(Z[(tk + t) * LDZ + ZC_QA + hq * 128 + d]) * sc * bf2f(Z[(tk + s) * LDZ + ZC_KA + hq * 128 + d]) * expf(-fabsf(BB[t * 128 + d] - BB[s * 128 + d]));
                AT[i] = a; }
            __threadfence(); __syncthreads();
            for (int i = tid; i < 64 * 256; i += 512) { const int t = i >> 8, dv = i & 255; float o = 0.f;
                for (int s = 0; s < 64; ++s) o += AT[t * 64 + s] * bf2f(Z[(tk + s) * LDZ + ZC_VA + hq * 256 + dv]);
                for (int d = 0; d < 128; ++d) o += bf2f(Z[(tk + t) * LDZ + ZC_QA + hq * 128 + d]) * sc * expf(BB[t * 128 + d]) * ST[d * 256 + dv];
                EXP[((size_t)c * 64 + t) * 256 + dv] = o; }
            __threadfence(); __syncthreads();
            for (int i = tid; i < 128 * 256; i += 512) { const int d = i >> 8, dv = i & 255; float s_ = ST[i] * expf(BB[63 * 128 + d]);
                for (int s = 0; s < 64; ++s) s_ += bf2f(Z[(tk + s) * LDZ + ZC_KA + hq * 128 + d]) * expf(BB[63 * 128 + d] - BB[s * 128 + d]) * bf2f(Z[(tk + s) * LDZ + ZC_VA + hq * 256 + dv]);
                ST[i] = s_; }
            __threadfence(); __syncthreads();
        }
    }
    GRID_SYNC();
#endif
#if DIAG == 12
    {
        const int tid = fresh_tid(); float* EXP = (float*)(ws + 470 * MiB); const size_t t = (size_t)blockIdx.x * 128 + (tid & 127); const int d0 = (tid >> 7) * 32; const int hd = DIAG_HD;
        if (blockIdx.x == 0 && tid == 0) { *(unsigned*)(ws + 500 * MiB) = 0u; *((unsigned*)(ws + 500 * MiB) + 64) = 0u; }
        const long sb0 = (long)(t / SEQ) * SEQ;
        float o[32]; for (int e = 0; e < 32; ++e) o[e] = 0.f; float after = 0.f;
        for (long s = (long)t - 1; s >= sb0; --s) { float z = 0.f; for (int d = 0; d < 128; ++d) z += bf2f(Z[t * LDZ + ZC_QB + hd * 128 + d]) * bf2f(Z[(size_t)s * LDZ + ZC_KB + hd * 128 + d]);
            z *= 0.08838834764831845f;
            const float sp = log1pf(expf(-fabsf(z))); const float lsig = fminf(z, 0.f) - sp, l1m = fminf(-z, 0.f) - sp;
            const float w = expf(lsig + after); after += l1m;
            for (int e = 0; e < 32; ++e) o[e] += w * bf2f(Z[(size_t)s * LDZ + ZC_VB + hd * 128 + d0 + e]);
            if (after < -120.f) break; }
        for (int e = 0; e < 32; ++e) EXP[t * 128 + d0 + e] = o[e];
        __threadfence(); __syncthreads();
    }
    GRID_SYNC();
#endif
#if DIAG == 11
    if (blockIdx.x == 0) {
        const int tid = fresh_tid();
        float* EXP = (float*)(ws + 460 * MiB); float* BB = EXP + 128 * 256; float* ST = BB + 128 * 128;
        const float* LRp = (const float*)(ws + WS_LR);
        for (int i = tid; i < 128 * 128; i += 512) { const int t = i >> 7, d = i & 127; float pre = P.b_alpha[d];
            for (int r = 0; r < 16; ++r) pre += LRp[t * 16 + r] * P.w_alpha[r * 512 + d];
            const float ls = fminf(pre, 0.f) - log1pf(expf(-fabsf(pre))); BB[i] = ls / 16.f; }
        __threadfence(); __syncthreads();
        if (tid < 256) { const int d = tid & 127, ch = tid >> 7; float run = 0.f; for (int t = 0; t < 64; ++t) { run += BB[(ch * 64 + t) * 128 + d]; BB[(ch * 64 + t) * 128 + d] = run; } }
        __threadfence(); __syncthreads();
        const float sc = 0.08838834764831845f;
        for (int i = tid; i < 64 * 256; i += 512) { const int t = i >> 8, dv = i & 255; float o = 0.f;
            for (int s = 0; s < 64; ++s) { float a = 0.f; for (int d = 0; d < 128; ++d) { const float q = bf2f(Z[(size_t)t * LDZ + d]) * sc, k = bf2f(Z[(size_t)s * LDZ + 512 + d]);
                    a += q * k * expf(-fabsf(BB[t * 128 + d] - BB[s * 128 + d])); }
                o += a * bf2f(Z[(size_t)s * LDZ + 1024 + dv]); }
            EXP[t * 256 + dv] = o; }
        for (int i = tid; i < 128 * 256; i += 512) { const int d = i >> 8, dv = i & 255; float s_ = 0.f;
            for (int s = 0; s < 64; ++s) s_ += bf2f(Z[(size_t)s * LDZ + 512 + d]) * expf(BB[63 * 128 + d] - BB[s * 128 + d]) * bf2f(Z[(size_t)s * LDZ + 1024 + dv]);
            ST[i] = s_; }
        __threadfence(); __syncthreads();
        for (int i = tid; i < 64 * 256; i += 512) { const int t = 64 + (i >> 8), dv = i & 255; float o = 0.f;
            for (int s = 64; s < 128; ++s) { float a = 0.f; for (int d = 0; d < 128; ++d) { const float q = bf2f(Z[(size_t)t * LDZ + d]) * sc, k = bf2f(Z[(size_t)s * LDZ + 512 + d]);
                    a += q * k * expf(-fabsf(BB[t * 128 + d] - BB[s * 128 + d])); }
                o += a * bf2f(Z[(size_t)s * LDZ + 1024 + dv]); }
            for (int d = 0; d < 128; ++d) o += bf2f(Z[(size_t)t * LDZ + d]) * sc * expf(BB[t * 128 + d]) * ST[d * 256 + dv];
            EXP[t * 256 + dv] = o; }
        __threadfence(); __syncthreads();
    }
    GRID_SYNC();
#endif
#if DIAG != 3 && DIAG != 4 && DIAG != 8 && DIAG != 5 && DIAG != 6
    { const int tid = fresh_tid(); for (int u = blockIdx.x; u < 1024; u += G) sb_unit(P, lds, (G == 256) ? ((u & 7) * 128 + (u >> 3)) : u, tid); }
    __syncthreads();
    { const int tid = fresh_tid();
      if (G == 256) { const int x = blockIdx.x & 7, j = blockIdx.x >> 3;
          for (int kk = 0; kk < 8; ++kk) { const int li = j * 8 + kk, c = li >> 1, h = 2 * (x & 1) + (li & 1), b = x >> 1; gla_prep_unit(P, lds, (b * 128 + c) * 4 + h, tid); } }
      else for (int u = blockIdx.x; u < 2048; u += G) gla_prep_unit(P, lds, u, tid); }
    }
    if (BOTH(2)) GRID_SYNC();
    STAMP(3);
    if (IN(3)) {
#if DIAG == 10
    { const int tid = fresh_tid(); const bf16_t* ATTd = (const bf16_t*)(ws + WS_ATTN); const float* DECd = (const float*)(ws + WS_DEC);
      for (size_t i = (size_t)blockIdx.x * 512 + tid; i < (size_t)NTOK * 1024; i += (size_t)G * 512) { const size_t r = i >> 10, c = i & 1023;
          P.out[i] = bf2f(Z[r * LDZ + c]) + 2.f * bf2f(ATTd[i & 0x7FFFFF]) + 4.f * DECd[i & 0x3FFFF]; } return; }
#endif
    {
        const int tid = fresh_tid(); const int wave = __builtin_amdgcn_readfirstlane(tid >> 6), lane = tid & 63;
        for (int u = blockIdx.x; u < 256; u += G) gla_scan_unit2(P, lds, (G == 256) ? ((u & 7) * 32 + (u >> 3)) : u, wave, lane);
    }
#endif
    }
    if (BOTH(3)) GRID_SYNC();
    STAMP(4);
    if (IN(4)) {
#if DIAG == 7
    { const int tid = fresh_tid(); const float* SSAd = (const float*)(ws + WS_SSA);
      for (size_t i = (size_t)blockIdx.x * 512 + tid; i < (size_t)NTOK * 1024; i += (size_t)G * 512) { const size_t r = i >> 10, c = i & 1023;
#if DIAG7_SEL == 0
          P.out[i] = bf2f(Z[r * LDZ + ZC_OB + c]); } return; }
#elif DIAG7_SEL == 1
          P.out[i] = bf2f(Z[r * LDZ + ZC_OA + c]); } return; }
#else
          P.out[i] = SSAd[r * 64 + (c & 63)]; } return; }
#endif
#endif
#if DIAG == 13
    { const int tid = fresh_tid(); float* SC = (float*)(ws + 460 * MiB) + (size_t)blockIdx.x * 4096; const size_t r0 = (size_t)blockIdx.x * 128 + 37;
      if (blockIdx.x == 0 && tid == 0) { *(unsigned*)(ws + 500 * MiB) = 0u; *((unsigned*)(ws + 500 * MiB) + 64) = 0u; }
        for (int i = tid; i < 1024; i += 512) { SC[i] = bf2f(Z[r0 * LDZ + ZC_OA + i]); SC[1024 + i] = bf2f(Z[r0 * LDZ + ZC_OB + i]); }
        if (tid < 64) SC[2048 + tid] = ((const float*)(ws + WS_SSA))[r0 * 64 + tid];
        __threadfence(); __syncthreads(); }
    GRID_SYNC();
#endif
#if DIAG == 15
    {   const int tid = fresh_tid(); const float* EXP = (const float*)(ws + 470 * MiB); LAS float* red = (LAS float*)lds; float* PC = (float*)(ws + 500 * MiB + 4096);
        if (blockIdx.x < 128) { const int c = blockIdx.x; float se = 0.f, sr = 0.f;
            for (int i = tid; i < 64 * 256; i += 512) { const size_t t = (size_t)c * 64 + (i >> 8); const int dv = i & 255;
                const float e = EXP[t * 256 + dv], g = bf2f(Z[((size_t)DIAG_B * SEQ + t) * LDZ + ZC_OA + DIAG_H * 256 + dv]); se += (e - g) * (e - g); sr += e * e; }
            red[tid] = se; red[512 + tid] = sr; __syncthreads();
            if (tid == 0) { float a = 0.f, b = 0.f; for (int i = 0; i < 512; ++i) { a += red[i]; b += red[512 + i]; } PC[c] = sqrtf(a / b); }
        }
        __threadfence(); __syncthreads();
    }
    GRID_SYNC();
    { const int tid = fresh_tid(); const float* PC = (const float*)(ws + 500 * MiB + 4096); int cnt = 0;
      for (int c = 0; c < 128; ++c) { const float v = __hip_atomic_load(PC + c, __ATOMIC_RELAXED, __HIP_MEMORY_SCOPE_AGENT); if (v > 0.03f) ++cnt; }
      const float cst = (float)cnt;
      for (size_t i = (size_t)blockIdx.x * 512 + tid; i < (size_t)NTOK * 1024; i += (size_t)G * 512) P.out[i] = cst; }
    return;
#endif
#if DIAG == 12
    {   const int tid = fresh_tid(); const float* EXP = (const float*)(ws + 470 * MiB); int bad = 0; unsigned badrow = 0;
        for (size_t i = (size_t)blockIdx.x * 512 + tid; i < (size_t)NTOK * 128; i += (size_t)G * 512) { const size_t t = i >> 7; const int d = (int)(i & 127);
            const float e = EXP[i], g = bf2f(Z[t * LDZ + ZC_OB + DIAG_HD * 128 + d]); if (fabsf(e - g) > 0.05f) { ++bad; badrow = (unsigned)(t & 8191) + 1u; } }
        if (bad) { atomicAdd((unsigned*)(ws + 500 * MiB), (unsigned)bad); atomicMax((unsigned*)(ws + 500 * MiB) + 64, badrow); }
        __threadfence(); __syncthreads();
    }
    GRID_SYNC();
    { const int tid = fresh_tid(); const float cst = (float)__hip_atomic_load((const unsigned*)(ws + 500 * MiB) + DIAG13_WHICH * 64, __ATOMIC_RELAXED, __HIP_MEMORY_SCOPE_AGENT);
      for (size_t i = (size_t)blockIdx.x * 512 + tid; i < (size_t)NTOK * 1024; i += (size_t)G * 512) P.out[i] = cst; }
    return;
#endif
#if DIAG == 11
    {
        const int tid = fresh_tid(); const float* EXP = (const float*)(ws + 460 * MiB);
        LAS float* red = (LAS float*)lds;
        float md = 0.f, mx = 0.f;
        for (int i = tid; i < 128 * 256; i += 512) { const int t = i >> 8, dv = i & 255; const float e = EXP[i], g = bf2f(Z[(size_t)t * LDZ + ZC_OA + dv]); md = fmaxf(md, fabsf(e - g)); mx = fmaxf(mx, fabsf(e)); }
        red[tid] = md; red[512 + tid] = mx; __syncthreads();
        if (tid == 0) { float a = 0.f, b = 0.f; for (int i = 0; i < 512; ++i) { a = fmaxf(a, red[i]); b = fmaxf(b, red[512 + i]); } red[1024] = 1.f + 100.f * a / fmaxf(b, 1e-20f); }
        __syncthreads();
        const float cst = red[1024];
        for (size_t i = (size_t)blockIdx.x * 512 + tid; i < (size_t)NTOK * 1024; i += (size_t)G * 512) P.out[i] = cst;
        return;
    }
#endif
    {
        pg8::Gemm g{H, (const bf16_t*)(ws + WS_W4T), H, (const bf16_t*)(ws + WS_W4T), NTOK, 4096, 1024, 1024};
        pg8::StaticOrder S; S.init(NTOK, 4096, G, (int)blockIdx.x);
        EpiGates E{Z, (const float*)(ws + WS_SSA), P.g_gla, Z, (bf16_t*)(ws + (DIAG == 8 ? 448 : 416) * MiB)};
        pg8::gemm_phase<EpiGates, pg8::StaticOrder, false, true>(lds, g, S, E);
    }
    }
    if (BOTH(4)) GRID_SYNC();
    STAMP(5);
    if (IN(5)) {
#if DIAG == 8
    {
        const int tid = fresh_tid(); const bf16_t* SGX = (const bf16_t*)(ws + 448 * MiB);
        for (size_t i = (size_t)blockIdx.x * 512 + tid; i < (size_t)NTOK * 1024; i += (size_t)G * 512) P.out[i] = bf2f(SGX[i]);
        return;
    }
#endif
#if DIAG == 4
    {
        const int tid = fresh_tid();
        for (size_t i = (size_t)blockIdx.x * 512 + tid; i < (size_t)NTOK * 1024; i += (size_t)G * 512) { const size_t r = i >> 10, c = i & 1023;
            const unsigned sgw = __hip_atomic_load((const unsigned*)P.out + i, __ATOMIC_RELAXED, __HIP_MEMORY_SCOPE_AGENT);
#if DIAG4_SGONLY
            P.out[i] = bflo(sgw) + bfhi(sgw); }
#else
            P.out[i] = bf2f(Z[r * LDZ + ZC_OA + c]) + bf2f(Z[r * LDZ + ZC_OB + c]) + bflo(sgw) + bfhi(sgw); }
#endif
        return;
    }
#endif
#if DIAG == 6
    { const int tid = fresh_tid(); for (size_t i = (size_t)blockIdx.x * 512 + tid; i < (size_t)NTOK * 1024; i += (size_t)G * 512) { const size_t r = i >> 10, c = i & 1023; P.out[i] = bf2f(Z[r * LDZ + c]); } return; }
#endif
    {
        pg8::Gemm g{Z + ZC_OA, (const bf16_t*)(ws + WS_WG), Z + ZC_OB, (const bf16_t*)(ws + WS_WS), NTOK, 1024, 1024, LDZ};
        PairOrder S; S.init(NTOK, 1024, G, (int)blockIdx.x);
        EpiMerge E{Z + ZC_VA, Z};
        pg8::gemm_phase<EpiMerge, PairOrder, true, true>(lds, g, S, E);
    }
    }
    if (BOTH(5)) GRID_SYNC();
    STAMP(6);
    if (IN(6)) {
#if DIAG == 6
#endif
#if DIAG == 5
    { const int tid = fresh_tid(); for (size_t i = (size_t)blockIdx.x * 512 + tid; i < (size_t)NTOK * 1024; i += (size_t)G * 512) { const size_t r = i >> 10, c = i & 1023; P.out[i] = bf2f(Z[r * LDZ + ZC_VA + c]); } return; }
#endif
    {
        pg8::Gemm g{Z + ZC_VA, (const bf16_t*)(ws + WS_WO), Z + ZC_VA, (const bf16_t*)(ws + WS_WO), NTOK, 1024, 1024, LDZ};
        pg8::StaticOrder S; S.init(NTOK, 1024, G, (int)blockIdx.x);
        EpiX1 E{P.x, Z, (float*)(ws + WS_SS1)};
        pg8::gemm_phase<EpiX1, pg8::StaticOrder, true, true>(lds, g, S, E);
    }
    }
    if (BOTH(6)) GRID_SYNC();
    STAMP(7);
    if (IN(7)) {
    {
        pg8::Gemm g{(const bf16_t*)(ws + WS_PB), (const bf16_t*)(ws + WS_WPE), (const bf16_t*)(ws + WS_PB), (const bf16_t*)(ws + WS_WPE), NTOK, 1024, 256, 256};
        pg8::StaticOrder S; S.init(NTOK, 1024, G, (int)blockIdx.x);
        EpiPE E{Z};
        pg8::gemm_phase<EpiPE, pg8::StaticOrder, true, true>(lds, g, S, E);
    }
    {
        pg8::Gemm g{Z, (const bf16_t*)(ws + WS_WPG), Z, (const bf16_t*)(ws + WS_WPG), NTOK, 1024, 1024, LDZ};
        pg8::StaticOrder S; S.init(NTOK, 1024, G, (int)blockIdx.x);
        EpiX2 E{Z, (const float*)(ws + WS_SS1), (float*)(ws + WS_SS2)};
        pg8::gemm_phase<EpiX2, pg8::StaticOrder, true, true>(lds, g, S, E);
    }
    }
    if (BOTH(7)) GRID_SYNC();
    STAMP(8);
    if (IN(8)) {
    {
        const int tid = fresh_tid(); const int wave = tid >> 6, lane = tid & 63;
        const float* SS2 = (const float*)(ws + WS_SS2);
        for (int it = 0; it < (NTOK + G * 8 - 1) / (G * 8); ++it) {
            const int m = (G == 256) ? (4096 * (int)(blockIdx.x & 7) + 128 * (int)(blockIdx.x >> 3) + 16 * wave + it) : ((int)blockIdx.x * 8 + wave + it * G * 8);
            if (m >= NTOK) break;
            const f32x4* sp = (const f32x4*)(SS2 + (size_t)m * 16); const f32x4 a = sp[0], b = sp[1], c4 = sp[2], d = sp[3];
            const float s = ((a.x + a.y) + (a.z + a.w)) + ((b.x + b.y) + (b.z + b.w)) + ((c4.x + c4.y) + (c4.z + c4.w)) + ((d.x + d.y) + (d.z + d.w));
            const float rstd = rsqrtf(s * (1.f / 1024.f) + EPS);
            const f32x4* xi = (const f32x4*)(Z + (size_t)m * LDZ + 2048) + lane; f32x4* xr = (f32x4*)(P.out + (size_t)m * DM) + lane;
#pragma unroll
            for (int j = 0; j < 4; ++j) { const f32x4 g4 = ((const f32x4*)P.g_final)[64 * j + lane]; xr[64 * j] = xi[64 * j] * rstd * g4; }
        }
    }
    }
#if DIAG == 13
    GRID_SYNC();
    {
        const int tid = fresh_tid(); const size_t r0 = (size_t)blockIdx.x * 128 + 37; const float* SC = (const float*)(ws + 460 * MiB) + (size_t)blockIdx.x * 4096; float* T = (float*)(ws + 470 * MiB) + (size_t)blockIdx.x * 16384;
        float* hrow = T, *A1 = T + 1024, *A2 = T + 2048, *mg = T + 3072, *x1 = T + 4096, *uu = T + 5120, *x2 = T + 6144, *sm = T + 7168, *red = T + 9216;
        for (int i = tid; i < 1024; i += 512) hrow[i] = bf2f(H[r0 * 1024 + i]);
        __threadfence(); __syncthreads();
        for (int n = tid; n < 4096; n += 512) { const int col = (n < 1024) ? 2064 + n : (n < 2048 ? 6160 + (n - 1024) : 7184 + (n - 2048)); float s = 0.f;
            for (int k = 0; k < 1024; ++k) s += hrow[k] * P.w_in[(size_t)k * 9232 + col];
            if (n < 1024) { float ss = 0.f; for (int j = 0; j < 16; ++j) ss += SC[2048 + (n >> 8) * 16 + j]; const float rstd = rsqrtf(ss / 256.f + EPS);
                A1[n] = SC[n] * rstd * P.g_gla[n] * (s / (1.f + expf(-s))); }
            else if (n < 2048) A2[n - 1024] = SC[1024 + (n - 1024)] * (s / (1.f + expf(-s)));
            else sm[n - 2048] = 1.f / (1.f + expf(-s)); }
        __threadfence(); __syncthreads();
        for (int n = tid; n < 1024; n += 512) { float ya = 0.f, yb = 0.f; for (int k = 0; k < 1024; ++k) { ya += A1[k] * P.w_out_gla[(size_t)k * 1024 + n]; yb += A2[k] * P.w_out_sb[(size_t)k * 1024 + n]; }
            mg[n] = sm[n] * ya + sm[1024 + n] * yb; }
        __threadfence(); __syncthreads();
        for (int n = tid; n < 1024; n += 512) { float s = 0.f; for (int k = 0; k < 1024; ++k) s += mg[k] * P.w_out[(size_t)k * 1024 + n]; x1[n] = P.x[r0 * 1024 + n] + s; }
        __threadfence(); __syncthreads();
        if (tid == 0) { float ss = 0.f; for (int k = 0; k < 1024; ++k) ss += x1[k] * x1[k]; red[0] = rsqrtf(ss / 1024.f + EPS); }
        __threadfence(); __syncthreads();
        for (int n = tid; n < 1024; n += 512) uu[n] = x1[n] * red[0] * P.g_ple[n];
        __threadfence(); __syncthreads();
        for (int n = tid; n < 1024; n += 512) { float s = 0.f, pe = 0.f; for (int k = 0; k < 1024; ++k) s += uu[k] * P.w_ple_gate[(size_t)k * 1024 + n];
            for (int k = 0; k < 256; ++k) pe += P.p[r0 * 256 + k] * P.w_ple[(size_t)k * 1024 + n];
            x2[n] = x1[n] + pe / (1.f + expf(-s)); }
        __threadfence(); __syncthreads();
        if (tid == 0) { float ss = 0.f; for (int k = 0; k < 1024; ++k) ss += x2[k] * x2[k]; const float rs = rsqrtf(ss / 1024.f + EPS); float md = 0.f, mx = 0.f;
            for (int k = 0; k < 1024; ++k) { const float e = x2[k] * rs * P.g_final[k]; md = fmaxf(md, fabsf(e - P.out[r0 * 1024 + k])); mx = fmaxf(mx, fabsf(e)); }
            if (md / mx > 0.05f) { atomicAdd((unsigned*)(ws + 500 * MiB), 1u); atomicMax((unsigned*)(ws + 500 * MiB) + 64, (unsigned)blockIdx.x + 1u); } }
        __threadfence(); __syncthreads();
    }
    GRID_SYNC();
    { const int tid = fresh_tid(); const float cst = (float)__hip_atomic_load((const unsigned*)(ws + 500 * MiB) + DIAG13_WHICH * 64, __ATOMIC_RELAXED, __HIP_MEMORY_SCOPE_AGENT);
      for (size_t i = (size_t)blockIdx.x * 512 + tid; i < (size_t)NTOK * 1024; i += (size_t)G * 512) P.out[i] = cst; }
#endif
#if DIAG == 20
    STAMP(9);
    GRID_SYNC();
    { const int tid = fresh_tid(); const unsigned long long* TS = (const unsigned long long*)(P.ws + 500 * MiB + 8192);
      const unsigned long long ta = __hip_atomic_load(TS + 0, __ATOMIC_RELAXED, __HIP_MEMORY_SCOPE_AGENT), tb = __hip_atomic_load(TS + 9, __ATOMIC_RELAXED, __HIP_MEMORY_SCOPE_AGENT);
      const unsigned long long t0 = __hip_atomic_load(TS + DIAG_T, __ATOMIC_RELAXED, __HIP_MEMORY_SCOPE_AGENT), t1 = __hip_atomic_load(TS + DIAG_T + 1, __ATOMIC_RELAXED, __HIP_MEMORY_SCOPE_AGENT);
      const float cst = floorf(99.f * (float)(t1 - t0) / (float)(tb - ta));
      for (size_t i = (size_t)blockIdx.x * 512 + tid; i < (size_t)NTOK * 1024; i += (size_t)G * 512) P.out[i] = cst; }
#endif
}

extern "C" void kernel_launch(void* const* d_in, const int* in_sizes, int n_in, void* d_out, int out_size, void* d_ws, size_t ws_size, hipStream_t stream) {
    static int grid = 0;
    if (grid == 0) {
        int dev = 0, cus = 0, per_cu = 0;
        hipGetDevice(&dev);
        hipDeviceGetAttribute(&cus, hipDeviceAttributeMultiprocessorCount, dev);
        hipFuncSetAttribute((const void*)fwd_kernel, hipFuncAttributeMaxDynamicSharedMemorySize, LDS_BYTES);
        hipOccupancyMaxActiveBlocksPerMultiprocessor(&per_cu, (const void*)fwd_kernel, 512, LDS_BYTES);
        if (per_cu < 1) per_cu = 1;
        grid = cus * per_cu;
        if (ws_size < 460 * MiB) fprintf(stderr, "kernel_launch: workspace too small: %zu\n", ws_size);
    }
#if !USE_CG_SYNC
    (void)hipMemsetAsync(d_ws, 0, 1 << 20, stream);
#endif
    Params p{};
    p.x = (const float*)d_in[0]; p.p = (const float*)d_in[1]; p.g_mix = (const float*)d_in[2]; p.w_in = (const float*)d_in[3];
    p.w_alpha = (const float*)d_in[4]; p.b_alpha = (const float*)d_in[5]; p.g_gla = (const float*)d_in[6]; p.w_out_gla = (const float*)d_in[7];
    p.w_out_sb = (const float*)d_in[8]; p.w_out = (const float*)d_in[9]; p.g_ple = (const float*)d_in[10]; p.w_ple_gate = (const float*)d_in[11];
    p.w_ple = (const float*)d_in[12]; p.g_final = (const float*)d_in[13];
    p.out = (float*)d_out; p.ws = (unsigned char*)d_ws;
#if N_LAUNCHES == 1
    p.ph_lo = 0; p.ph_hi = 9;
    void* args[] = {&p};
    hipError_t e = hipLaunchCooperativeKernel((const void*)fwd_kernel, dim3(grid), dim3(512), args, LDS_BYTES, stream);
    if (e != hipSuccess) fprintf(stderr, "cooperative launch failed: %s (grid %d)\n", hipGetErrorString(e), grid);
#else
    for (int k = 0; k < 9; ++k) { p.ph_lo = k; p.ph_hi = k + 1; hipLaunchKernelGGL(fwd_kernel, dim3(grid), dim3(512), LDS_BYTES, stream, p); }
#endif
}
```

```cpp
#include <hip/hip_runtime.h>
#include <hip/hip_cooperative_groups.h>
#include <cstdio>
#include <cstdint>
namespace cg = cooperative_groups;
namespace pg8 {
#define PG8_LAS __attribute__((address_space(3)))
typedef unsigned short bf16_t;
typedef short bf16x8 __attribute__((ext_vector_type(8)));
typedef float f32x4 __attribute__((ext_vector_type(4)));
typedef unsigned u32x4 __attribute__((ext_vector_type(4)));
constexpr int BM = 256, BK = 64, HALF = 128, HTB = HALF * BK * 2  , STAGE_BYTES = 8 * HTB, NXCD = 8, WGM = 8;

__host__ __device__ __forceinline__ int lds_byte(int r, int c) { const int st = (r >> 4) * 2 + (c >> 5), rr = r & 15, cc = c & 31, ob = rr * 64 + cc * 2; return st * 1024 + (ob ^ (((ob >> 9) & 1) << 5)); }
__host__ __device__ __forceinline__ void stage_rc(int b, int& R, int& C) { const int st = b / 1024, sb = b % 1024, swz = sb ^ (((sb >> 9) & 1) << 5); R = (st >> 1) * 16 + swz / 64; C = (st & 1) * 32 + (swz % 64) / 2; }
__host__ __device__ __forceinline__ int perm32(int rho) { const int n = rho >> 4, i = rho & 15; return 8 * (i >> 2) + 4 * n + (i & 3); }

struct Unit { int pm, pn, sel; };
struct Gemm { const bf16_t* A; const bf16_t* Bt; const bf16_t* A2; const bf16_t* Bt2; int M, N, K, lda; };

struct StaticOrder {
    int nM, nN, nwg, G, c;
    __host__ __device__ void init(int M, int N, int G_, int c_) { nM = M / BM; nN = N / BM; nwg = nM * nN; G = G_; c = c_; }
    __host__ __device__ bool next(int i, Unit& u) const {
        const long L = (long)i * G + c; if (L >= nwg) return false;
        int wgid = (int)L; { const int q = nwg / NXCD, r = nwg % NXCD, xcd = wgid % NXCD, off = wgid / NXCD; wgid = (xcd < r ? xcd * (q + 1) : r * (q + 1) + (xcd - r) * q) + off; }
        const int nig = WGM * nN, gid = wgid / nig, fm = gid * WGM, gsz = (nM - fm) < WGM ? (nM - fm) : WGM;
        u.pm = fm + ((wgid % nig) % gsz); u.pn = (wgid % nig) / gsz; u.sel = 0; return true;
    }
    __device__ __forceinline__ void a_ready(const Unit&) const {}
    __device__ __forceinline__ void done(const Unit&) const {}
};

__device__ __forceinline__ unsigned cvt_pk_bf16(float lo, float hi) { unsigned r; asm volatile("v_cvt_pk_bf16_f32 %0, %1, %2" : "=v"(r) : "v"(lo), "v"(hi)); return r; }
typedef float f32x2 __attribute__((ext_vector_type(2)));
__device__ __forceinline__ f32x2 gelu_pk(f32x2 v) {
    const f32x2 av = __builtin_elementwise_abs(v), d = av * 0.2316418882f + 1.0f;
    f32x2 t; t.x = __builtin_amdgcn_rcpf(d.x); t.y = __builtin_amdgcn_rcpf(d.y);
    f32x2 q = t * 0.5307027145f + (-0.7265760135f); q = q * t + 0.7107068705f; q = q * t + (-0.142248368f); q = q * t + 0.127414796f; q = q * t;
    const f32x2 s = (v * v) * (-0.72134752044f);
    f32x2 e; e.x = __builtin_amdgcn_exp2f(s.x); e.y = __builtin_amdgcn_exp2f(s.y);
    const f32x2 m = v * (q * e), r = v - m;
    f32x2 o; o.x = v.x < 0.f ? m.x : r.x; o.y = v.y < 0.f ? m.y : r.y; return o;
}

template <int ACT  > struct EpiBf16 {
    static constexpr bool PERM = true, AFTER_DRAIN = false; static_assert(ACT == 0 || ACT == 1, "EpiBf16: ACT is 0 (none) or 1 (gelu_pk)");
    bf16_t* O; int ldc; const float* bias; int split_cols; size_t split_stride; float scale0;
    __device__ __forceinline__ void operator()(const f32x4 (&acc)[2][2][4][2], const Unit& u, int wr, int wc, int fr, int fq) const {
        const int row0 = u.pm * BM + wr * 64 + fr; int colt = u.pn * BM; bf16_t* base = O;
        float sc = 1.f; if (split_cols) { const int t = colt / split_cols; base += (size_t)t * split_stride; colt -= t * split_cols; if (t == 0) sc = scale0; }
        const int col0 = colt + wc * 32 + 8 * fq, bcol0 = u.pn * BM + wc * 32 + 8 * fq;
        f32x4 bv[2][2];
#pragma unroll
        for (int bj = 0; bj < 2; ++bj)
#pragma unroll
            for (int n = 0; n < 2; ++n) bv[bj][n] = bias ? *(const f32x4*)(bias + bcol0 + bj * HALF + 4 * n) : (f32x4){0.f, 0.f, 0.f, 0.f};
#pragma unroll
        for (int ai = 0; ai < 2; ++ai)
#pragma unroll
            for (int m = 0; m < 4; ++m) { bf16_t* rowp = base + (size_t)(row0 + ai * HALF + m * 16) * ldc + col0;
#pragma unroll
                for (int bj = 0; bj < 2; ++bj) { f32x4 v0 = acc[ai][bj][m][0] + bv[bj][0], v1 = acc[ai][bj][m][1] + bv[bj][1];
                    if (ACT == 1) { f32x2 a = gelu_pk((f32x2){v0[0], v0[1]}), b = gelu_pk((f32x2){v0[2], v0[3]}), c = gelu_pk((f32x2){v1[0], v1[1]}), d = gelu_pk((f32x2){v1[2], v1[3]});
                        v0 = (f32x4){a.x, a.y, b.x, b.y}; v1 = (f32x4){c.x, c.y, d.x, d.y}; }
                    v0 = v0 * sc; v1 = v1 * sc; u32x4 w; w.x = cvt_pk_bf16(v0[0], v0[1]); w.y = cvt_pk_bf16(v0[2], v0[3]); w.z = cvt_pk_bf16(v1[0], v1[1]); w.w = cvt_pk_bf16(v1[2], v1[3]);
                    *(u32x4*)(rowp + bj * HALF) = w; } }
    }
};

struct PanelStats {
    unsigned* xbuf;
    unsigned* cnt;
    unsigned* tmo;
    int ntn; float eps;
    unsigned code;
    __device__ __forceinline__ bool run(const f32x4 (&v)[2][2][4][2], const Unit& u, int wr, int wc, int fr, int fq, PG8_LAS unsigned char* lds, int wid, int lane) const {
        typedef float f32x2v __attribute__((ext_vector_type(2)));
        PG8_LAS f32x2v* P = (PG8_LAS f32x2v*)lds;
        PG8_LAS f32x2v* S = (PG8_LAS f32x2v*)(lds + 8192);
        PG8_LAS unsigned* flag = (PG8_LAS unsigned*)(lds + 8192 + 2048);
#pragma unroll
        for (int ai = 0; ai < 2; ++ai)
#pragma unroll
            for (int m = 0; m < 4; ++m) {
                float s = 0.f;
#pragma unroll
                for (int bj = 0; bj < 2; ++bj)
#pragma unroll
                    for (int n = 0; n < 2; ++n) { const f32x4 x = v[ai][bj][m][n]; s += (x[0] + x[1]) + (x[2] + x[3]); }
                s += __shfl_xor(s, 16); s += __shfl_xor(s, 32);
                const float mw = s * (1.0f / 64.0f); float q = 0.f;
#pragma unroll
                for (int bj = 0; bj < 2; ++bj)
#pragma unroll
                    for (int n = 0; n < 2; ++n) { const f32x4 d = v[ai][bj][m][n] - mw; q += (d[0] * d[0] + d[1] * d[1]) + (d[2] * d[2] + d[3] * d[3]); }
                q += __shfl_xor(q, 16); q += __shfl_xor(q, 32);
                if (fq == 0) P[(ai * HALF + wr * 64 + m * 16 + fr) * 4 + wc] = (f32x2v){mw, q};
            }
        asm volatile("s_waitcnt lgkmcnt(0)" ::: "memory"); __builtin_amdgcn_s_barrier(); asm volatile("" ::: "memory");
#if defined(BROKEN_EXCHANGE_NO_WAIT)
#warning BROKEN CONTROL BUILD: the row-statistics exchange does not wait; results are wrong by design
        if (blockIdx.x >= 64) { const long long t0_ = clock64(); while (clock64() - t0_ < 60000) __builtin_amdgcn_s_sleep(8); }
#endif
        const int row = wid * 32 + (lane & 31);
        if (lane < 32) {
            const f32x2v a = P[row * 4 + 0], b = P[row * 4 + 1], c = P[row * 4 + 2], d = P[row * 4 + 3];
            const float mt = (a.x + b.x + c.x + d.x) * 0.25f;
            const float da = a.x - mt, db = b.x - mt, dc = c.x - mt, dd = d.x - mt;
            const float m2 = (a.y + b.y) + (c.y + d.y) + 64.0f * ((da * da + db * db) + (dc * dc + dd * dd));
            unsigned long long* slot = (unsigned long long*)xbuf + ((size_t)(u.pm * BM + row) * 4 + u.pn);
            __hip_atomic_store(slot, ((unsigned long long)__float_as_uint(m2) << 32) | __float_as_uint(mt), __ATOMIC_RELAXED, __HIP_MEMORY_SCOPE_AGENT);
        }
        asm volatile("s_waitcnt vmcnt(0)" ::: "memory");
        if (lane == 0) __hip_atomic_fetch_add(cnt + 64 * u.pm, 1u, __ATOMIC_RELAXED, __HIP_MEMORY_SCOPE_AGENT);
        if (wid == 0) {
            bool dead = false; const unsigned long long t0 = __builtin_amdgcn_s_memrealtime(); const unsigned want = 8u * (unsigned)ntn;
            for (;;) {
#if defined(BROKEN_EXCHANGE_NO_WAIT)
                break;
#endif
                if ((unsigned)__builtin_amdgcn_readfirstlane(__hip_atomic_load(cnt + 64 * u.pm, __ATOMIC_RELAXED, __HIP_MEMORY_SCOPE_AGENT)) >= want) break;
                if (__builtin_amdgcn_s_memrealtime() - t0 > 2000000ull) {
                    if (lane == 0) { unsigned expect = 0u; __hip_atomic_compare_exchange_strong(tmo + 1, &expect, code | (unsigned)(u.pm & 0xff), __ATOMIC_RELAXED, __ATOMIC_RELAXED, __HIP_MEMORY_SCOPE_AGENT);
                                     __hip_atomic_store(tmo, 1u, __ATOMIC_RELAXED, __HIP_MEMORY_SCOPE_AGENT); }
                    dead = true; break; }
                __builtin_amdgcn_s_sleep(2);
            }
            __builtin_amdgcn_fence(__ATOMIC_ACQUIRE, "agent");
            if (lane == 0) flag[0] = dead ? 1u : 0u;
        }
        asm volatile("s_waitcnt vmcnt(0) lgkmcnt(0)" ::: "memory"); __builtin_amdgcn_s_barrier(); asm volatile("" ::: "memory");
        const bool bad = flag[0] != 0u;
        if (lane < 32) {
            const unsigned long long* slot = (const unsigned long long*)xbuf + (size_t)(u.pm * BM + row) * 4; float mt[4], m2[4]; float ms = 0.f;
#pragma unroll
            for (int t = 0; t < 4; ++t) { if (t < ntn) { const unsigned long long w = __hip_atomic_load(slot + t, __ATOMIC_RELAXED, __HIP_MEMORY_SCOPE_AGENT); mt[t] = __uint_as_float((unsigned)w); m2[t] = __uint_as_float((unsigned)(w >> 32)); } else { mt[t] = 0.f; m2[t] = 0.f; } ms += mt[t]; }
            const float mean = ms / (float)ntn; float q = 0.f;
#pragma unroll
            for (int t = 0; t < 4; ++t) if (t < ntn) { const float dm = mt[t] - mean; q += m2[t] + 256.0f * dm * dm; }
            S[row] = (f32x2v){mean, 1.0f / sqrtf(q / (256.0f * (float)ntn) + eps)};
        }
        asm volatile("s_waitcnt lgkmcnt(0)" ::: "memory"); __builtin_amdgcn_s_barrier(); asm volatile("" ::: "memory");
        return bad;
    }
};
struct EpiLnRes {
    static constexpr bool PERM = false, AFTER_DRAIN = true;
    const float* base; float* out; int ldc; const float* bias; PanelStats st; unsigned poison;
    __device__ __forceinline__ void fused(f32x4 (&acc)[2][2][4][2], const Unit& u, int wr, int wc, int fr, int fq, PG8_LAS unsigned char* lds, int wid, int lane) const {
        typedef float f32x2v __attribute__((ext_vector_type(2)));
        const PG8_LAS f32x2v* S = (const PG8_LAS f32x2v*)(lds + 8192);
        const int col0 = u.pn * BM + wc * 32 + 4 * fq;
#pragma unroll
        for (int bj = 0; bj < 2; ++bj)
#pragma unroll
            for (int n = 0; n < 2; ++n) { const f32x4 bv = bias ? *(const f32x4*)(bias + col0 + bj * HALF + n * 16) : (f32x4){0.f, 0.f, 0.f, 0.f};
#pragma unroll
                for (int ai = 0; ai < 2; ++ai)
#pragma unroll
                    for (int m = 0; m < 4; ++m) acc[ai][bj][m][n] += bv; }
        f32x4 pre[4][2][2];
#pragma unroll
        for (int m = 0; m < 4; ++m) { const size_t off = (size_t)(u.pm * BM + wr * 64 + m * 16 + fr) * ldc + col0;
#pragma unroll
            for (int bj = 0; bj < 2; ++bj)
#pragma unroll
                for (int n = 0; n < 2; ++n) pre[m][bj][n] = *(const f32x4*)(base + off + bj * HALF + n * 16); }
        const bool bad = st.run(acc, u, wr, wc, fr, fq, lds, wid, lane) || poison != 0u;
        const float qnan = __builtin_nanf("");
#pragma unroll
        for (int ai = 0; ai < 2; ++ai)
#pragma unroll
            for (int m = 0; m < 4; ++m) { const int r = ai * HALF + wr * 64 + m * 16 + fr; const f32x2v sr = S[r]; const size_t off = (size_t)(u.pm * BM + r) * ldc + col0;
#pragma unroll
                for (int bj = 0; bj < 2; ++bj)
#pragma unroll
                    for (int n = 0; n < 2; ++n) { const f32x4 bs = ai == 0 ? pre[m][bj][n] : *(const f32x4*)(base + off + bj * HALF + n * 16); f32x4 o = bs + (acc[ai][bj][m][n] - sr.x) * sr.y;
                        if (bad) o = (f32x4){qnan, qnan, qnan, qnan}; *(f32x4*)(out + off + bj * HALF + n * 16) = o; }
                if (m & 1) asm volatile("" ::: "memory"); }
    }
};
struct EpiLnResLn {
    static constexpr bool PERM = false, AFTER_DRAIN = true;
    const float* base; float* out; bf16_t* xn; int ldc; const float* bias; PanelStats st1, st2; unsigned poison;
    __device__ __forceinline__ void fused(f32x4 (&acc)[2][2][4][2], const Unit& u, int wr, int wc, int fr, int fq, PG8_LAS unsigned char* lds, int wid, int lane) const {
        typedef float f32x2v __attribute__((ext_vector_type(2))); typedef unsigned u32x2v __attribute__((ext_vector_type(2)));
        const PG8_LAS f32x2v* S = (const PG8_LAS f32x2v*)(lds + 8192);
        const int col0 = u.pn * BM + wc * 32 + 4 * fq;
#pragma unroll
        for (int bj = 0; bj < 2; ++bj)
#pragma unroll
            for (int n = 0; n < 2; ++n) { const f32x4 bv = bias ? *(const f32x4*)(bias + col0 + bj * HALF + n * 16) : (f32x4){0.f, 0.f, 0.f, 0.f};
#pragma unroll
                for (int ai = 0; ai < 2; ++ai)
#pragma unroll
                    for (int m = 0; m < 4; ++m) acc[ai][bj][m][n] += bv; }
        bool bad = st1.run(acc, u, wr, wc, fr, fq, lds, wid, lane) || poison != 0u;
        const float qnan = __builtin_nanf("");
#pragma unroll
        for (int ai = 0; ai < 2; ++ai)
#pragma unroll
            for (int m = 0; m < 4; ++m) { const int r = ai * HALF + wr * 64 + m * 16 + fr; const f32x2v sr = S[r]; const size_t off = (size_t)(u.pm * BM + r) * ldc + col0;
#pragma unroll
                for (int bj = 0; bj < 2; ++bj)
#pragma unroll
                    for (int n = 0; n < 2; ++n) { const f32x4 bs = *(const f32x4*)(base + off + bj * HALF + n * 16); acc[ai][bj][m][n] = bs + (acc[ai][bj][m][n] - sr.x) * sr.y; }
                asm volatile("" : "+v"(acc[ai][0][m][0]), "+v"(acc[ai][0][m][1]), "+v"(acc[ai][1][m][0]), "+v"(acc[ai][1][m][1]));
                if (m & 1) asm volatile("" ::: "memory"); }
        const bool bad1 = bad;
        bad = st2.run(acc, u, wr, wc, fr, fq, lds, wid, lane) || bad;
#pragma unroll
        for (int ai = 0; ai < 2; ++ai)
#pragma unroll
            for (int m = 0; m < 4; ++m) { const int r = ai * HALF + wr * 64 + m * 16 + fr; const f32x2v sr = S[r]; const size_t off = (size_t)(u.pm * BM + r) * ldc + col0;
#pragma unroll
                for (int bj = 0; bj < 2; ++bj)
#pragma unroll
                    for (int n = 0; n < 2; ++n) { const f32x4 x1 = acc[ai][bj][m][n]; *(f32x4*)(out + off + bj * HALF + n * 16) = bad1 ? (f32x4){qnan, qnan, qnan, qnan} : x1;
                        const f32x4 o = (x1 - sr.x) * sr.y; u32x2v w; w.x = cvt_pk_bf16(o[0], o[1]); w.y = cvt_pk_bf16(o[2], o[3]);
                        if (bad) { w.x = 0x7fc07fc0u; w.y = 0x7fc07fc0u; } *(u32x2v*)(xn + off + bj * HALF + n * 16) = w; }
                asm volatile("" ::: "memory"); }
    }
};

template <class Epi, class Sched, bool ALIGN_EPI = false, bool SP2 = false>
__device__ __forceinline__ void gemm_phase(PG8_LAS unsigned char* lds, const Gemm g, const Sched& S, const Epi& E) {
    int tid_ = threadIdx.x; asm volatile("" : "+v"(tid_)); const int tid = tid_, wid = __builtin_amdgcn_readfirstlane(tid >> 6), lane = tid & 63, wr = wid >> 2, wc = wid & 3, fr = lane & 15, fq = lane >> 4;
    const int K = g.K, nt = K / BK;
    unsigned voffA[2], voffB[2];
#pragma unroll
    for (int i = 0; i < 2; ++i) { int R, C; stage_rc(tid * 16 + i * 8192, R, C); const int Rb = Epi::PERM ? ((R & ~31) + perm32(R & 31)) : R;
        voffA[i] = (unsigned)(R * g.lda + C) * 2u; voffB[i] = (unsigned)(Rb * K + C) * 2u; }
    const size_t kstep = (size_t)(BK * 2);
    const size_t hstepA = (size_t)HALF * g.lda * 2, hstepB = (size_t)HALF * K * 2;
    const size_t tstepA = 2 * hstepA, tstepB = 2 * hstepB;
    const unsigned ldsw = (unsigned)wid * 1024u;
    const int aoff = lds_byte(wr * 64 + fr, fq * 8), boff = lds_byte(wc * 32 + fr, fq * 8);
#define PG8_SA(b, h) (((b) * 2 + (h)) * HTB)
#define PG8_SB(b, h) ((4 + (b) * 2 + (h)) * HTB)
#define PG8_STAGE(bufoff, gbase, voff) do { _Pragma("unroll") for (int _i = 0; _i < 2; ++_i) \
        __builtin_amdgcn_global_load_lds((const unsigned*)((const char*)(gbase) + (voff)[_i]), (PG8_LAS unsigned*)(lds + (bufoff) + ldsw + _i * 8192), 16, 0, 0); } while (0)
#define PG8_LDA(dst, b, h) do { _Pragma("unroll") for (int m = 0; m < 4; ++m) _Pragma("unroll") for (int k = 0; k < 2; ++k) dst[m][k] = *(const PG8_LAS bf16x8*)(lds + PG8_SA(b, h) + aoff + m * 2048 + k * 1024); } while (0)
#define PG8_LDB(dst, b, h) do { _Pragma("unroll") for (int n = 0; n < 2; ++n) _Pragma("unroll") for (int k = 0; k < 2; ++k) dst[n][k] = *(const PG8_LAS bf16x8*)(lds + PG8_SB(b, h) + boff + n * 2048 + k * 1024); } while (0)
#define PG8_MMA(ai, bj, At, Bt) do { __builtin_amdgcn_s_setprio(1); _Pragma("unroll") for (int m = 0; m < 4; ++m) _Pragma("unroll") for (int n = 0; n < 2; ++n) _Pragma("unroll") for (int k = 0; k < 2; ++k) \
        acc[ai][bj][m][n] = __builtin_amdgcn_mfma_f32_16x16x32_bf16(Bt[n][k], At[m][k], acc[ai][bj][m][n], 0, 0, 0); __builtin_amdgcn_s_setprio(0); } while (0)
#define PG8_WAIT_V(n) asm volatile("s_waitcnt vmcnt(" #n ")" ::: "memory")
#define PG8_WAIT_L(n) asm volatile("s_waitcnt lgkmcnt(" #n ")" ::: "memory")
#define PG8_BAR __builtin_amdgcn_s_barrier()
#define PG8_SCHED __builtin_amdgcn_sched_barrier(0)
    Unit cur, nxt; int ui = 0;
    if (!S.next(0, cur)) return;
    f32x4 acc[2][2][4][2];
#pragma unroll
    for (int a = 0; a < 2; ++a)
#pragma unroll
        for (int b = 0; b < 2; ++b)
#pragma unroll
            for (int m = 0; m < 4; ++m)
#pragma unroll
                for (int n = 0; n < 2; ++n) acc[a][b][m][n] = (f32x4){0.f, 0.f, 0.f, 0.f};
    bf16x8 At[4][2], B0[2][2], B1[2][2];
    const char* cA = (const char*)(cur.sel ? g.A2 : g.A) + (size_t)cur.pm * tstepA; const char* cB = (const char*)(cur.sel ? g.Bt2 : g.Bt) + (size_t)cur.pn * tstepB;
    S.a_ready(cur);
    if constexpr (SP2) {
        PG8_STAGE(PG8_SB(0, 0), cB, voffB); PG8_STAGE(PG8_SB(0, 1), cB + hstepB, voffB); PG8_STAGE(PG8_SA(0, 0), cA, voffA); PG8_STAGE(PG8_SA(0, 1), cA + hstepA, voffA);
        if (wr == 1) PG8_BAR;
        PG8_WAIT_V(2); PG8_BAR;
        PG8_STAGE(PG8_SB(1, 0), cB + kstep, voffB); PG8_STAGE(PG8_SA(1, 0), cA + kstep, voffA); PG8_STAGE(PG8_SB(1, 1), cB + hstepB + kstep, voffB);
        PG8_WAIT_V(6); PG8_BAR;
    } else {
        PG8_STAGE(PG8_SB(0, 0), cB, voffB); PG8_STAGE(PG8_SA(0, 0), cA, voffA); PG8_STAGE(PG8_SB(0, 1), cB + hstepB, voffB); PG8_STAGE(PG8_SA(0, 1), cA + hstepA, voffA);
        if (wr == 1) PG8_BAR;
        PG8_WAIT_V(4); PG8_BAR;
        PG8_STAGE(PG8_SB(1, 0), cB + kstep, voffB); PG8_STAGE(PG8_SA(1, 0), cA + kstep, voffA); PG8_STAGE(PG8_SB(1, 1), cB + hstepB + kstep, voffB);
        PG8_WAIT_V(6); PG8_BAR;
    }
    for (;;) {
        const bool has_next = S.next(ui + 1, nxt);
        const char* nA = has_next ? (const char*)(nxt.sel ? g.A2 : g.A) + (size_t)nxt.pm * tstepA : cA; const char* nB = has_next ? (const char*)(nxt.sel ? g.Bt2 : g.Bt) + (size_t)nxt.pn * tstepB : cB;
        for (int t = 0; t < nt; t += 2) {
            const bool last = (t == nt - 2);
            const char* a1 = cA + (size_t)(t + 1) * kstep;
            const char* a2 = last ? nA : cA + (size_t)(t + 2) * kstep; const char* b2 = last ? nB : cB + (size_t)(t + 2) * kstep;
            const char* a3 = a2 + kstep; const char* b3 = b2 + kstep;
            if (last && has_next) S.a_ready(nxt);
            if constexpr (SP2) {
            PG8_LDB(B0, 0, 0); PG8_LDB(B1, 0, 1); PG8_SCHED; PG8_LDA(At, 0, 0); PG8_STAGE(PG8_SA(1, 1), a1 + hstepA, voffA);
            PG8_WAIT_V(8); PG8_WAIT_L(0); PG8_BAR; PG8_MMA(0, 0, At, B0); PG8_MMA(0, 1, At, B1); PG8_BAR; PG8_SCHED;
            PG8_LDA(At, 0, 1); PG8_STAGE(PG8_SB(0, 0), b2, voffB); PG8_STAGE(PG8_SB(0, 1), b2 + hstepB, voffB); PG8_STAGE(PG8_SA(0, 0), a2, voffA);
            PG8_WAIT_V(8); PG8_WAIT_L(0); PG8_BAR; PG8_MMA(1, 0, At, B0); PG8_MMA(1, 1, At, B1); PG8_BAR; PG8_SCHED;
            PG8_LDB(B0, 1, 0); PG8_LDB(B1, 1, 1); PG8_SCHED; PG8_LDA(At, 1, 0); PG8_STAGE(PG8_SA(0, 1), a2 + hstepA, voffA);
            PG8_WAIT_V(8); PG8_WAIT_L(0); PG8_BAR; PG8_MMA(0, 0, At, B0); PG8_MMA(0, 1, At, B1); PG8_BAR; PG8_SCHED;
            PG8_LDA(At, 1, 1); PG8_STAGE(PG8_SB(1, 0), b3, voffB); PG8_STAGE(PG8_SB(1, 1), b3 + hstepB, voffB); PG8_STAGE(PG8_SA(1, 0), a3, voffA);
            PG8_WAIT_V(8); PG8_WAIT_L(0); PG8_BAR; PG8_MMA(1, 0, At, B0); PG8_MMA(1, 1, At, B1); PG8_BAR; PG8_SCHED;
            } else {
            PG8_LDB(B0, 0, 0); PG8_SCHED; PG8_LDA(At, 0, 0); PG8_STAGE(PG8_SA(1, 1), a1 + hstepA, voffA);
            PG8_WAIT_L(8); PG8_BAR; PG8_WAIT_L(0); PG8_MMA(0, 0, At, B0); PG8_BAR; PG8_SCHED;
            PG8_LDB(B1, 0, 1); PG8_STAGE(PG8_SB(0, 0), b2, voffB);
            PG8_BAR; PG8_WAIT_L(0); PG8_MMA(0, 1, At, B1); PG8_BAR;
            PG8_LDA(At, 0, 1); PG8_STAGE(PG8_SA(0, 0), a2, voffA);
            PG8_BAR; PG8_WAIT_L(0); PG8_MMA(1, 0, At, B0); PG8_BAR; PG8_SCHED;
            PG8_STAGE(PG8_SB(0, 1), b2 + hstepB, voffB);
            PG8_WAIT_V(6); PG8_BAR; PG8_MMA(1, 1, At, B1); PG8_BAR;
            PG8_LDB(B0, 1, 0); PG8_SCHED; PG8_LDA(At, 1, 0); PG8_STAGE(PG8_SA(0, 1), a2 + hstepA, voffA);
            PG8_WAIT_L(8); PG8_BAR; PG8_WAIT_L(0); PG8_MMA(0, 0, At, B0); PG8_BAR; PG8_SCHED;
            PG8_LDB(B1, 1, 1); PG8_STAGE(PG8_SB(1, 0), b3, voffB);
            PG8_BAR; PG8_WAIT_L(0); PG8_MMA(0, 1, At, B1); PG8_BAR;
            PG8_LDA(At, 1, 1); PG8_STAGE(PG8_SA(1, 0), a3, voffA);
            PG8_BAR; PG8_WAIT_L(0); PG8_MMA(1, 0, At, B0); PG8_BAR; PG8_SCHED;
            PG8_STAGE(PG8_SB(1, 1), b3 + hstepB, voffB);
            PG8_WAIT_V(6); PG8_BAR; PG8_MMA(1, 1, At, B1); PG8_BAR;
            }
        }
        if constexpr (ALIGN_EPI) { if (wr == 0) PG8_BAR; }
        if constexpr (!Epi::AFTER_DRAIN) { E(acc, cur, wr, wc, fr, fq); S.done(cur); }
        if (!has_next) break;
#pragma unroll
        for (int a = 0; a < 2; ++a)
#pragma unroll
            for (int b = 0; b < 2; ++b)
#pragma unroll
                for (int m = 0; m < 4; ++m)
#pragma unroll
                    for (int n = 0; n < 2; ++n) acc[a][b][m][n] = (f32x4){0.f, 0.f, 0.f, 0.f};
        cur = nxt; cA = nA; cB = nB; ++ui;
        if constexpr (ALIGN_EPI) { if (wr == 1) PG8_BAR; }
    }
    PG8_WAIT_V(0);
    if constexpr (!ALIGN_EPI) { if (wr == 0) PG8_BAR; }
    PG8_BAR;
    if constexpr (Epi::AFTER_DRAIN) { E.fused(acc, cur, wr, wc, fr, fq, lds, wid, lane); S.done(cur); }
#undef PG8_SA
#undef PG8_SB
#undef PG8_STAGE
#undef PG8_LDA
#undef PG8_LDB
#undef PG8_MMA
#undef PG8_WAIT_V
#undef PG8_WAIT_L
#undef PG8_BAR
#undef PG8_SCHED
}
}
#define XB_TMO      128
#define XB_XCNT(j)  (256  + 64 * (j))
#define XB_XSUB(j)  (1280 + 64 * (j))
#define XB_XGEN(j)  (2304 + 64 * (j))
#define XB_TOP      3328
#define XB_TOPGEN   3392
#define XCD_BAR_WORDS 3456
#define XB_SPIN_CAP (1u << 18)

__device__ __forceinline__ unsigned xb_ld(unsigned* p)              { return __hip_atomic_load(p, __ATOMIC_RELAXED, __HIP_MEMORY_SCOPE_AGENT); }
__device__ __forceinline__ unsigned xb_add(unsigned* p, unsigned v) { return __hip_atomic_fetch_add(p, v, __ATOMIC_RELAXED, __HIP_MEMORY_SCOPE_AGENT); }
__device__ __forceinline__ unsigned xb_xcc_id() { return (unsigned)__builtin_amdgcn_s_getreg((3 << 11) | 20) & 0xFu; }
#define XB_SPIN(cond, bar) do { unsigned _sp = 0; while (cond) { __builtin_amdgcn_s_sleep(1); \
    if ((++_sp & 255u) == 0u) { if (xb_ld(&(bar)[XB_TMO])) break; if (_sp > XB_SPIN_CAP) { atomicAdd(&(bar)[XB_TMO], 1u); break; } } } } while (0)

struct XcdBarrier {
    unsigned* bar; unsigned x;
    volatile __attribute__((address_space(3))) unsigned* st;
};

__device__ __forceinline__ XcdBarrier xcd_barrier_post(unsigned* bar, volatile __attribute__((address_space(3))) unsigned* st) {
    XcdBarrier b; b.bar = bar; b.x = xb_xcc_id(); b.st = st;
    if (threadIdx.x == 0) (void)xb_add(&bar[XB_XCNT(b.x)], 1u);
    return b;
}
__device__ __forceinline__ void xcd_barrier_complete(unsigned* bar, unsigned x, unsigned& nloc, unsigned& nx) {
    const unsigned G = gridDim.x * gridDim.y * gridDim.z;
    unsigned sum, cnt, mine, sp = 0u;
    for (;;) {
        sum = 0u; cnt = 0u; mine = 0u;
#pragma unroll
        for (unsigned j = 0; j < 16; ++j) { const unsigned c = xb_ld(&bar[XB_XCNT(j)]); sum += c; cnt += (c > 0u) ? 1u : 0u; mine = (j == x) ? c : mine; }
        if (sum == G) break;
        __builtin_amdgcn_s_sleep(1);
        if ((++sp & 255u) == 0u) { if (xb_ld(&bar[XB_TMO])) break; if (sp > XB_SPIN_CAP) { atomicAdd(&bar[XB_TMO], 1u); break; } }
    }
    nloc = mine > 0u ? mine : 1u; nx = cnt > 0u ? cnt : 1u;
}

__device__ __forceinline__ void xcd_barrier(const XcdBarrier& b) {
    asm volatile("s_waitcnt vmcnt(0)" ::: "memory");
    __syncthreads();
    if (threadIdx.x == 0) {
        unsigned* bar = b.bar;
        __builtin_amdgcn_s_waitcnt(0);
        unsigned nloc = b.st[0], nx = b.st[1];
        if (nloc == 0u) { xcd_barrier_complete(bar, b.x, nloc, nx); b.st[0] = nloc; b.st[1] = nx; }
        const unsigned old = xb_add(&bar[XB_XSUB(b.x)], 1u);
        const unsigned gen = old / nloc;
        if (old + 1u == (gen + 1u) * nloc) {
            __builtin_amdgcn_fence(__ATOMIC_RELEASE, "agent");
            asm volatile("s_waitcnt vmcnt(0)" ::: "memory");
            const unsigned og = xb_add(&bar[XB_TOP], 1u);
            const unsigned tg = og / nx;
            if (og + 1u == (tg + 1u) * nx) xb_add(&bar[XB_TOPGEN], 1u);
            else XB_SPIN(xb_ld(&bar[XB_TOPGEN]) == tg, bar);
            __builtin_amdgcn_fence(__ATOMIC_ACQUIRE, "agent");
            xb_add(&bar[XB_XGEN(b.x)], 1u);
            asm volatile("s_waitcnt vmcnt(0)" ::: "memory");
        } else {
            XB_SPIN(xb_ld(&bar[XB_XGEN(b.x)]) == gen, bar);
            __builtin_amdgcn_fence(__ATOMIC_ACQUIRE, "agent");
            asm volatile("s_waitcnt vmcnt(0)" ::: "memory");
        }
    }
    __syncthreads();
}

#define LAS __attribute__((address_space(3)))
typedef unsigned short bf16_t;
typedef short bf16x8 __attribute__((ext_vector_type(8)));
typedef short s16x4 __attribute__((ext_vector_type(4)));
typedef float f32x4 __attribute__((ext_vector_type(4)));
typedef float f32x16 __attribute__((ext_vector_type(16)));
typedef unsigned u32x4 __attribute__((ext_vector_type(4)));
typedef unsigned u32x2 __attribute__((ext_vector_type(2)));

constexpr int NTOK = 32768, DM = 1024, SEQ = 8192, LDZ = 5120;
constexpr float EPS = 1e-6f;
constexpr size_t MiB = (size_t)1 << 20;
constexpr size_t WS_W1T = 1 * MiB, WS_W4T = 12 * MiB, WS_WG = 20 * MiB, WS_WS = 22 * MiB, WS_WO = 24 * MiB, WS_WPG = 26 * MiB, WS_WPE = 28 * MiB;
constexpr size_t WS_LR = 29 * MiB, WS_DEC = 31 * MiB, WS_H = 32 * MiB, WS_Z1 = 96 * MiB, WS_ATTN = 416 * MiB, WS_PB = 432 * MiB, WS_SSA = 448 * MiB, WS_SS1 = 456 * MiB, WS_SS2 = 458 * MiB;
constexpr size_t WS_X1F = 96 * MiB, WS_X1B = 224 * MiB, WS_PE = 288 * MiB;
constexpr int LDS_BYTES = 147456;
#ifndef P5_NO_RMW
#define P5_NO_RMW 0
#endif
#ifndef N_LAUNCHES
#define N_LAUNCHES 1
#endif
#ifndef DIAG7_SEL
#define DIAG7_SEL 0
#endif
#ifndef SCAN_DIRECT_V
#define SCAN_DIRECT_V 2
#endif
#ifndef DIAG13_WHICH
#define DIAG13_WHICH 0
#endif
#ifndef DIAG14_ROW
#define DIAG14_ROW 37
#endif
#ifndef DIAG_HD
#define DIAG_HD 5
#endif
#ifndef DIAG_B
#define DIAG_B 1
#define DIAG_H 2
#endif
#ifndef DIAG_CLO
#define DIAG_CLO 0
#define DIAG_CHI 128
#endif
#ifndef DIAG_T
#define DIAG_T 2
#endif
#ifndef SYS_INV
#define SYS_INV 0
#endif
#ifndef DIAG4_SGONLY
#define DIAG4_SGONLY 1
#endif
#ifndef DIAG
#define DIAG 0
#endif
#ifndef USE_CG_SYNC
#define USE_CG_SYNC 0
#endif
constexpr int ZC_QA = 0, ZC_KA = 512, ZC_VA = 1024, ZC_QB = 2048, ZC_KB = 3072, ZC_VB = 4096, ZC_OA = 3072, ZC_OB = 2048;

struct Params {
    const float* x; const float* p; const float* g_mix; const float* w_in; const float* w_alpha; const float* b_alpha;
    const float* g_gla; const float* w_out_gla; const float* w_out_sb; const float* w_out; const float* g_ple;
    const float* w_ple_gate; const float* w_ple; const float* g_final;
    float* out; unsigned char* ws;
    int ph_lo, ph_hi;
};

__device__ __forceinline__ unsigned cvt_pk(float lo, float hi) { unsigned r; asm volatile("v_cvt_pk_bf16_f32 %0, %1, %2" : "=v"(r) : "v"(lo), "v"(hi)); return r; }
__device__ __forceinline__ bf16_t f2bf(float f) { return (bf16_t)(cvt_pk(f, 0.f) & 0xffffu); }
__device__ __forceinline__ float bf2f(unsigned h) { return __uint_as_float(h << 16); }
__device__ __forceinline__ float bflo(unsigned w) { return __uint_as_float(w << 16); }
__device__ __forceinline__ float bfhi(unsigned w) { return __uint_as_float(w & 0xffff0000u); }
__device__ __forceinline__ float fexp2(float x) { return __builtin_amdgcn_exp2f(x); }
__device__ __forceinline__ float flog2(float x) { return __builtin_amdgcn_logf(x); }
__device__ __forceinline__ float fexp(float x) { return __builtin_amdgcn_exp2f(x * 1.4426950408889634f); }
__device__ __forceinline__ float frcp(float x) { return __builtin_amdgcn_rcpf(x); }
__device__ __forceinline__ float sigmoidf_(float a) { return frcp(1.0f + fexp(-a)); }
__device__ __forceinline__ float siluf_(float a) { return a * sigmoidf_(a); }
__device__ __forceinline__ float logsigmoidf_(float x) { return fminf(x, 0.f) - 0.6931471805599453f * flog2(1.0f + fexp(-fabsf(x))); }
__device__ __forceinline__ float wave_sum(float v) {
#pragma unroll
    for (int o = 1; o < 64; o <<= 1) v += __shfl_xor(v, o);
    return v;
}
__device__ __forceinline__ int fresh_tid() { int t = threadIdx.x; asm volatile("" : "+v"(t)); return t; }
#define LDS_WAIT() asm volatile("s_waitcnt lgkmcnt(0)" ::: "memory")
#define VM_WAIT() asm volatile("s_waitcnt vmcnt(0)" ::: "memory")

__device__ __forceinline__ void p0_item(const float* W, int ldw, int src0, int nv, const float* rs, bf16_t* WT, int K, int n0, int k0, LAS float* scr, int lane) {
    const int c = lane & 31;
#pragma unroll 8
    for (int i = 0; i < 32; ++i) {
        const int kk = 2 * i + (lane >> 5);
        float v = 0.f;
        if (c < nv) v = W[(size_t)(k0 + kk) * ldw + src0 + c];
        if (rs) v *= rs[k0 + kk];
        scr[kk * 33 + c] = v;
    }
    LDS_WAIT(); asm volatile("" ::: "memory");
    const int c8 = lane & 7;
#pragma unroll
    for (int j = 0; j < 4; ++j) {
        const int n = (lane >> 3) + 8 * j; const LAS float* s = scr + (8 * c8) * 33 + n;
        u32x4 o; o.x = cvt_pk(s[0 * 33], s[1 * 33]); o.y = cvt_pk(s[2 * 33], s[3 * 33]); o.z = cvt_pk(s[4 * 33], s[5 * 33]); o.w = cvt_pk(s[6 * 33], s[7 * 33]);
        *(u32x4*)(WT + (size_t)(n0 + n) * K + k0 + 8 * c8) = o;
    }
    LDS_WAIT(); asm volatile("" ::: "memory");
}

__device__ __forceinline__ void phase0(const Params& P, LAS unsigned char* lds, int tid, int G) {
    const int wave = tid >> 6, lane = tid & 63;
    const int gw = blockIdx.x * 8 + wave, NGW = G * 8;
    LAS float* scr = (LAS float*)(lds + wave * 16384);
    unsigned char* ws = P.ws;
    constexpr int I_W1 = 16 * 168, I_W4 = 16 * 128, I_SQ = 16 * 32, I_PE = 4 * 32;
    constexpr int NIT = I_W1 + I_W4 + 4 * I_SQ + I_PE;
    for (int it = gw; it < NIT; it += NGW) {
        int r = it;
        if (r < I_W1) {
            const int kb = r / 168, nb = r % 168, n0 = nb * 32; int src, nv;
            if (n0 < 2048) { src = n0; nv = 32; } else if (n0 < 5120) { src = n0 + 1040; nv = 32; } else if (n0 == 5120) { src = 2048; nv = 16; } else { src = 0; nv = 0; }
            p0_item(P.w_in, 9232, src, nv, nullptr, (bf16_t*)(ws + WS_W1T), 1024, n0, kb * 64, scr, lane); continue;
        }
        r -= I_W1;
        if (r < I_W4) {
            const int kb = r / 128, nb = r % 128, n0 = nb * 32; const int src = (n0 < 1024) ? 2064 + n0 : n0 + 5136;
            p0_item(P.w_in, 9232, src, 32, nullptr, (bf16_t*)(ws + WS_W4T), 1024, n0, kb * 64, scr, lane); continue;
        }
        r -= I_W4;
        if (r < 4 * I_SQ) {
            const int which = r / I_SQ; r -= which * I_SQ; const int kb = r / 32, nb = r % 32;
            const float* W = which == 0 ? P.w_out_gla : which == 1 ? P.w_out_sb : which == 2 ? P.w_out : P.w_ple_gate;
            bf16_t* dst = (bf16_t*)(ws + (which == 0 ? WS_WG : which == 1 ? WS_WS : which == 2 ? WS_WO : WS_WPG));
            p0_item(W, 1024, nb * 32, 32, which == 3 ? P.g_ple : nullptr, dst, 1024, nb * 32, kb * 64, scr, lane); continue;
        }
        r -= 4 * I_SQ;
        { const int kb = r / 32, nb = r % 32; p0_item(P.w_ple, 1024, nb * 32, 32, nullptr, (bf16_t*)(ws + WS_WPE), 256, nb * 32, kb * 64, scr, lane); }
    }
    bf16_t* H = (bf16_t*)(ws + WS_H);
    for (int m = gw; m < NTOK; m += NGW) {
        const f32x4* xr = (const f32x4*)(P.x + (size_t)m * DM) + lane; f32x4 v[4]; float s2 = 0.f;
#pragma unroll
        for (int j = 0; j < 4; ++j) { v[j] = xr[64 * j]; s2 += (v[j].x * v[j].x + v[j].y * v[j].y) + (v[j].z * v[j].z + v[j].w * v[j].w); }
        const float rstd = rsqrtf(wave_sum(s2) * (1.f / DM) + EPS);
        unsigned long long* o8 = (unsigned long long*)(H + (size_t)m * DM) + lane;
#pragma unroll
        for (int j = 0; j < 4; ++j) { const f32x4 g4 = ((const f32x4*)P.g_mix)[64 * j + lane]; const f32x4 o = v[j] * rstd * g4;
            o8[64 * j] = (unsigned long long)cvt_pk(o.x, o.y) | ((unsigned long long)cvt_pk(o.z, o.w) << 32); }
    }
    u32x4* PB = (u32x4*)(ws + WS_PB);
    for (int i = blockIdx.x * 512 + tid; i < NTOK * 256 / 8; i += G * 512) {
        const f32x4 a = ((const f32x4*)P.p)[2 * i], b = ((const f32x4*)P.p)[2 * i + 1];
        u32x4 o; o.x = cvt_pk(a.x, a.y); o.y = cvt_pk(a.z, a.w); o.z = cvt_pk(b.x, b.y); o.w = cvt_pk(b.z, b.w); PB[i] = o;
    }
}

typedef f32x4 AccT[2][2][4][2];
struct EpiZ1 {
    static constexpr bool PERM = true, AFTER_DRAIN = false;
    bf16_t* Z; float* LR;
    __device__ __forceinline__ void operator()(const AccT& acc, const pg8::Unit& u, int wr, int wc, int fr, int fq) const {
        const int row0 = u.pm * 256 + wr * 64 + fr;
        if (u.pn < 20) {
            const int col0 = u.pn * 256 + wc * 32 + 8 * fq;
#pragma unroll
            for (int ai = 0; ai < 2; ++ai)
#pragma unroll
                for (int m = 0; m < 4; ++m) { bf16_t* rowp = Z + (size_t)(row0 + ai * 128 + m * 16) * LDZ + col0;
#pragma unroll
                    for (int bj = 0; bj < 2; ++bj) { const f32x4 v0 = acc[ai][bj][m][0], v1 = acc[ai][bj][m][1];
                        u32x4 w; w.x = cvt_pk(v0[0], v0[1]); w.y = cvt_pk(v0[2], v0[3]); w.z = cvt_pk(v1[0], v1[1]); w.w = cvt_pk(v1[2], v1[3]);
                        *(u32x4*)(rowp + bj * 128) = w; } }
        } else if (wc == 0 && fq < 2) {
#pragma unroll
            for (int ai = 0; ai < 2; ++ai)
#pragma unroll
                for (int m = 0; m < 4; ++m) { float* lp = LR + (size_t)(row0 + ai * 128 + m * 16) * 16 + 8 * fq;
                    *(f32x4*)lp = acc[ai][0][m][0]; *(f32x4*)(lp + 4) = acc[ai][0][m][1]; }
        }
    }
};
struct EpiGates {
    static constexpr bool PERM = true, AFTER_DRAIN = false;
    bf16_t* Z; const float* SSA; const float* ggla; bf16_t* SG; bf16_t* SGX;
    __device__ __forceinline__ void operator()(const AccT& acc, const pg8::Unit& u, int wr, int wc, int fr, int fq) const {
        const int row0 = u.pm * 256 + wr * 64 + fr, cl = wc * 32 + 8 * fq;
        const int grp = u.pn >> 2;
        const int zc = (grp == 0 ? ZC_OA : grp == 1 ? ZC_OB : grp == 2 ? 0 : ZC_VB) + (u.pn & 3) * 256 + cl;
        f32x4 gv[2][2];
        if (grp == 0) {
#pragma unroll
            for (int bj = 0; bj < 2; ++bj) { const int c = (u.pn & 3) * 256 + bj * 128 + cl; gv[bj][0] = *(const f32x4*)(ggla + c); gv[bj][1] = *(const f32x4*)(ggla + c + 4); }
        }
#pragma unroll
        for (int ai = 0; ai < 2; ++ai)
#pragma unroll
        for (int mp = 0; mp < 2; ++mp) {
            u32x4 ov[2][2]; float rs[2];
            if (grp < 2) {
#pragma unroll
                for (int m = 2 * mp; m < 2 * mp + 2; ++m)
#pragma unroll
                    for (int bj = 0; bj < 2; ++bj) ov[m & 1][bj] = *(const u32x4*)(Z + (size_t)(row0 + ai * 128 + m * 16) * LDZ + zc + bj * 128);
            }
#pragma unroll
            for (int m = 2 * mp; m < 2 * mp + 2; ++m) { rs[m & 1] = 1.f;
                if (grp == 0) { const f32x4* sp = (const f32x4*)(SSA + (size_t)(row0 + ai * 128 + m * 16) * 64 + u.pn * 16); const f32x4 a = sp[0], b = sp[1], c = sp[2], d = sp[3];
                    const float s = ((a.x + a.y) + (a.z + a.w)) + ((b.x + b.y) + (b.z + b.w)) + ((c.x + c.y) + (c.z + c.w)) + ((d.x + d.y) + (d.z + d.w));
                    rs[m & 1] = rsqrtf(s * (1.f / 256.f) + EPS); } }
#pragma unroll
            for (int m = 2 * mp; m < 2 * mp + 2; ++m) {
                bf16_t* rowp = Z + (size_t)(row0 + ai * 128 + m * 16) * LDZ + zc;
#pragma unroll
                for (int bj = 0; bj < 2; ++bj) {
                    const f32x4 v0 = acc[ai][bj][m][0], v1 = acc[ai][bj][m][1];
                    float a[8] = {v0[0], v0[1], v0[2], v0[3], v1[0], v1[1], v1[2], v1[3]}; float o[8];
                    if (grp < 2) {
                        const u32x4 w_ = ov[m & 1][bj];
                        const float ovf[8] = {bflo(w_.x), bfhi(w_.x), bflo(w_.y), bfhi(w_.y), bflo(w_.z), bfhi(w_.z), bflo(w_.w), bfhi(w_.w)};
                        if (grp == 0) { const float gg[8] = {gv[bj][0].x, gv[bj][0].y, gv[bj][0].z, gv[bj][0].w, gv[bj][1].x, gv[bj][1].y, gv[bj][1].z, gv[bj][1].w};
#pragma unroll
                            for (int e = 0; e < 8; ++e) o[e] = ovf[e] * rs[m & 1] * gg[e] * siluf_(a[e]);
                        } else {
#pragma unroll
                            for (int e = 0; e < 8; ++e) o[e] = ovf[e] * siluf_(a[e]);
                        }
                    } else {
#pragma unroll
                        for (int e = 0; e < 8; ++e) o[e] = sigmoidf_(a[e]);
                    }
                    u32x4 w; w.x = cvt_pk(o[0], o[1]); w.y = cvt_pk(o[2], o[3]); w.z = cvt_pk(o[4], o[5]); w.w = cvt_pk(o[6], o[7]);
                    *(u32x4*)(rowp + bj * 128) = w;
                }
            }
        }
    }
};
struct EpiMerge {
    static constexpr bool PERM = true, AFTER_DRAIN = false;
    bf16_t* MG; const bf16_t* SG;
    __device__ __forceinline__ void operator()(const AccT& acc, const pg8::Unit& u, int wr, int wc, int fr, int fq) const {
        const int row0 = u.pm * 256 + wr * 64 + fr, cl = u.pn * 256 + wc * 32 + 8 * fq;
#pragma unroll
        for (int ai = 0; ai < 2; ++ai)
#pragma unroll
        for (int mp = 0; mp < 2; ++mp) {
            u32x4 sv[2][2], tv[2][2];
#pragma unroll
            for (int m = 2 * mp; m < 2 * mp + 2; ++m)
#pragma unroll
                for (int bj = 0; bj < 2; ++bj) { const size_t r = (size_t)(row0 + ai * 128 + m * 16); const int c = cl + bj * 128;
                    sv[m & 1][bj] = *(const u32x4*)(SG + r * LDZ + (u.sel ? ZC_VB : 0) + c);
                    if (u.sel) tv[m & 1][bj] = *(const u32x4*)(MG + r * LDZ + c); }
#pragma unroll
            for (int m = 2 * mp; m < 2 * mp + 2; ++m)
#pragma unroll
                for (int bj = 0; bj < 2; ++bj) {
                    const size_t r = (size_t)(row0 + ai * 128 + m * 16); const int c = cl + bj * 128;
                    const f32x4 v0 = acc[ai][bj][m][0], v1 = acc[ai][bj][m][1];
                    const float a[8] = {v0[0], v0[1], v0[2], v0[3], v1[0], v1[1], v1[2], v1[3]};
                    const u32x4 s_ = sv[m & 1][bj];
                    const float sg[8] = {bflo(s_.x), bfhi(s_.x), bflo(s_.y), bfhi(s_.y), bflo(s_.z), bfhi(s_.z), bflo(s_.w), bfhi(s_.w)};
                    float o[8];
                    if (u.sel) { const u32x4 t_ = tv[m & 1][bj];
                        const float tt[8] = {bflo(t_.x), bfhi(t_.x), bflo(t_.y), bfhi(t_.y), bflo(t_.z), bfhi(t_.z), bflo(t_.w), bfhi(t_.w)};
#pragma unroll
                        for (int e = 0; e < 8; ++e) o[e] = tt[e] + sg[e] * a[e];
                    } else {
#pragma unroll
                        for (int e = 0; e < 8; ++e) o[e] = sg[e] * a[e];
                    }
                    u32x4 w; w.x = cvt_pk(o[0], o[1]); w.y = cvt_pk(o[2], o[3]); w.z = cvt_pk(o[4], o[5]); w.w = cvt_pk(o[6], o[7]);
                    *(u32x4*)(MG + r * LDZ + c) = w;
                }
        }
    }
};
struct EpiX1 {
    static constexpr bool PERM = false, AFTER_DRAIN = false;
    const float* X; bf16_t* ZR; float* SS;
    __device__ __forceinline__ void operator()(const AccT& acc, const pg8::Unit& u, int wr, int wc, int fr, int fq) const {
        const int row0 = u.pm * 256 + wr * 64 + fr, cl = u.pn * 256 + wc * 32 + 4 * fq;
#pragma unroll
        for (int ai = 0; ai < 2; ++ai)
#pragma unroll
        for (int mp = 0; mp < 2; ++mp) {
            f32x4 xv[2][2][2];
#pragma unroll
            for (int m = 2 * mp; m < 2 * mp + 2; ++m)
#pragma unroll
                for (int bj = 0; bj < 2; ++bj)
#pragma unroll
                    for (int n = 0; n < 2; ++n) xv[m & 1][bj][n] = *(const f32x4*)(X + (size_t)(row0 + ai * 128 + m * 16) * 1024 + cl + bj * 128 + n * 16);
#pragma unroll
            for (int m = 2 * mp; m < 2 * mp + 2; ++m) {
                const int r = row0 + ai * 128 + m * 16; float ss = 0.f;
#pragma unroll
                for (int bj = 0; bj < 2; ++bj)
#pragma unroll
                    for (int n = 0; n < 2; ++n) {
                        const int c = cl + bj * 128 + n * 16;
                        const f32x4 v = xv[m & 1][bj][n] + acc[ai][bj][m][n];
                        *(f32x4*)((float*)(ZR + (size_t)r * LDZ + 2048) + c) = v;
                        u32x2 w; w.x = cvt_pk(v.x, v.y); w.y = cvt_pk(v.z, v.w); *(u32x2*)(ZR + (size_t)r * LDZ + c) = w;
                        ss += (v.x * v.x + v.y * v.y) + (v.z * v.z + v.w * v.w);
                    }
                ss += __shfl_xor(ss, 16); ss += __shfl_xor(ss, 32);
                if (fq == 0) SS[(size_t)r * 16 + u.pn * 4 + wc] = ss;
            }
        }
    }
};
struct EpiPE {
    static constexpr bool PERM = false, AFTER_DRAIN = false;
    bf16_t* PE;
    __device__ __forceinline__ void operator()(const AccT& acc, const pg8::Unit& u, int wr, int wc, int fr, int fq) const {
        const int row0 = u.pm * 256 + wr * 64 + fr, cl = u.pn * 256 + wc * 32 + 4 * fq;
#pragma unroll
        for (int ai = 0; ai < 2; ++ai)
#pragma unroll
            for (int m = 0; m < 4; ++m) {
                const int r = row0 + ai * 128 + m * 16;
#pragma unroll
                for (int bj = 0; bj < 2; ++bj)
#pragma unroll
                    for (int n = 0; n < 2; ++n) { const f32x4 v = acc[ai][bj][m][n]; u32x2 w; w.x = cvt_pk(v.x, v.y); w.y = cvt_pk(v.z, v.w);
                        *(u32x2*)(PE + (size_t)r * LDZ + ZC_VB + cl + bj * 128 + n * 16) = w; }
            }
    }
};
struct EpiX2 {
    static constexpr bool PERM = false, AFTER_DRAIN = false;
    bf16_t* ZR; const float* SS1; float* SS2;
    __device__ __forceinline__ void operator()(const AccT& acc, const pg8::Unit& u, int wr, int wc, int fr, int fq) const {
        const int row0 = u.pm * 256 + wr * 64 + fr, cl = u.pn * 256 + wc * 32 + 4 * fq;
#pragma unroll
        for (int ai = 0; ai < 2; ++ai)
#pragma unroll
            for (int m = 0; m < 4; ++m) {
                const int r = row0 + ai * 128 + m * 16;
                const f32x4* sp = (const f32x4*)(SS1 + (size_t)r * 16); const f32x4 a = sp[0], b = sp[1], c4 = sp[2], d = sp[3];
                const float s = ((a.x + a.y) + (a.z + a.w)) + ((b.x + b.y) + (b.z + b.w)) + ((c4.x + c4.y) + (c4.z + c4.w)) + ((d.x + d.y) + (d.z + d.w));
                const float rstd = rsqrtf(s * (1.f / 1024.f) + EPS);
                float ss = 0.f;
#pragma unroll
                for (int bj = 0; bj < 2; ++bj)
#pragma unroll
                    for (int n = 0; n < 2; ++n) {
                        const int c = cl + bj * 128 + n * 16;
                        float* xp = (float*)(ZR + (size_t)r * LDZ + 2048) + c;
                        const f32x4 x1 = *(const f32x4*)xp; const u32x2 pw = *(const u32x2*)(ZR + (size_t)r * LDZ + ZC_VB + c);
                        const f32x4 g = acc[ai][bj][m][n] * rstd;
                        f32x4 v;
                        v.x = x1.x + sigmoidf_(g.x) * bflo(pw.x); v.y = x1.y + sigmoidf_(g.y) * bfhi(pw.x);
                        v.z = x1.z + sigmoidf_(g.z) * bflo(pw.y); v.w = x1.w + sigmoidf_(g.w) * bfhi(pw.y);
                        *(f32x4*)xp = v;
                        ss += (v.x * v.x + v.y * v.y) + (v.z * v.z + v.w * v.w);
                    }
                ss += __shfl_xor(ss, 16); ss += __shfl_xor(ss, 32);
                if (fq == 0) SS2[(size_t)r * 16 + u.pn * 4 + wc] = ss;
            }
    }
};
struct PairOrder {
    pg8::StaticOrder base;
    __device__ void init(int M, int N, int G, int c) { base.init(M, N, G, c); }
    __device__ bool next(int i, pg8::Unit& u) const { if (!base.next(i >> 1, u)) return false; u.sel = i & 1; return true; }
    __device__ __forceinline__ void a_ready(const pg8::Unit&) const {}
    __device__ __forceinline__ void done(const pg8::Unit&) const {}
};

__device__ __forceinline__ int qperm(int dl) { return 8 * ((dl & 15) >> 2) + (dl & 3) + 4 * (dl >> 4); }
__device__ __forceinline__ void gla_prep_unit(const Params& P, LAS unsigned char* lds, int id, int tid) {
    const int b = id >> 9, c = (id >> 2) & 127, h = id & 3;
    const size_t tok0 = (size_t)b * SEQ + (size_t)c * 64;
    bf16_t* Z = (bf16_t*)(P.ws + WS_Z1);
    const float* LR = (const float*)(P.ws + WS_LR);
    float* DEC = (float*)(P.ws + WS_DEC);
    bf16_t* ATT = (bf16_t*)(P.ws + WS_ATTN);
    LAS bf16_t* QD = (LAS bf16_t*)lds; LAS bf16_t* KD = QD + 64 * 136; LAS bf16_t* QI = KD + 64 * 136; LAS bf16_t* KI = QI + 64 * 136;
    LAS float* lrs = (LAS float*)(lds + 4 * 64 * 136 * 2);
    LAS float* gs = lrs + 1024;
    const int d = tid & 127, tq = tid >> 7;
    if (tid < 256) ((LAS f32x4*)lrs)[tid] = ((const f32x4*)(LR + tok0 * 16))[tid];
    float wa[16];
#pragma unroll
    for (int r = 0; r < 16; ++r) wa[r] = P.w_alpha[r * 512 + h * 128 + d];
    const float ba = P.b_alpha[h * 128 + d];
    float qv[16], kv[16];
#pragma unroll
    for (int i = 0; i < 16; ++i) { const size_t row = tok0 + tq * 16 + i;
        qv[i] = bf2f(Z[row * LDZ + ZC_QA + h * 128 + d]); kv[i] = bf2f(Z[row * LDZ + ZC_KA + h * 128 + d]); }
    __syncthreads();
    float bc[16]; float run = 0.f;
#pragma unroll
    for (int i = 0; i < 16; ++i) { const int t = tq * 16 + i; float pre = ba;
#pragma unroll
        for (int r = 0; r < 16; ++r) pre += lrs[t * 16 + r] * wa[r];
        run += logsigmoidf_(pre) * (1.f / 16.f); bc[i] = run; }
    gs[tq * 128 + d] = run;
    VM_WAIT();
    __syncthreads();
    float off = 0.f, blast = 0.f;
#pragma unroll
    for (int g = 0; g < 4; ++g) { const float v = gs[g * 128 + d]; if (g < tq) off += v; blast += v; }
    const float scale = 0.08838834764831845f;
    float ke[16];
    const int dperm = (d & ~31) + qperm(d & 31);
#pragma unroll
    for (int i = 0; i < 16; ++i) {
        const float bb = bc[i] + off; const float eb = fexp(bb), enb = fexp(-bb);
        const int t = tq * 16 + i;
        const float qs = qv[i] * scale;
        const bf16_t qd = f2bf(qs * eb);
        QD[t * 136 + d] = qd; QI[t * 136 + d] = f2bf(qs * enb); KD[t * 136 + d] = f2bf(kv[i] * enb); KI[t * 136 + d] = f2bf(kv[i] * eb);
        Z[(tok0 + t) * LDZ + ZC_QA + h * 128 + dperm] = qd;
        ke[i] = kv[i] * fexp(blast - bb);
    }
    { u32x4 w0, w1; w0.x = cvt_pk(ke[0], ke[1]); w0.y = cvt_pk(ke[2], ke[3]); w0.z = cvt_pk(ke[4], ke[5]); w0.w = cvt_pk(ke[6], ke[7]);
      w1.x = cvt_pk(ke[8], ke[9]); w1.y = cvt_pk(ke[10], ke[11]); w1.z = cvt_pk(ke[12], ke[13]); w1.w = cvt_pk(ke[14], ke[15]);
      bf16_t* kp = Z + (tok0 + (d >> 1)) * LDZ + ZC_KA + h * 128 + (d & 1) * 64 + tq * 16;
      *(u32x4*)kp = w0; *(u32x4*)(kp + 8) = w1; }
    if (tq == 0) DEC[(size_t)id * 128 + d] = fexp(blast);
    __syncthreads();
    const int wave = tid >> 6, lane = tid & 63, fr = lane & 15, fq = lane >> 4;
#pragma unroll
    for (int tt = 0; tt < 2; ++tt) {
        const int tile = 2 * wave + tt, si = tile >> 2, ti = tile & 3;
        f32x4 ap = {0.f, 0.f, 0.f, 0.f}, af = {0.f, 0.f, 0.f, 0.f};
#pragma unroll
        for (int kk = 0; kk < 4; ++kk) {
            const bf16x8 a1 = *(const LAS bf16x8*)(KD + (16 * si + fr) * 136 + 32 * kk + 8 * fq), b1 = *(const LAS bf16x8*)(QD + (16 * ti + fr) * 136 + 32 * kk + 8 * fq);
            const bf16x8 a2 = *(const LAS bf16x8*)(KI + (16 * si + fr) * 136 + 32 * kk + 8 * fq), b2 = *(const LAS bf16x8*)(QI + (16 * ti + fr) * 136 + 32 * kk + 8 * fq);
            ap = __builtin_amdgcn_mfma_f32_16x16x32_bf16(a1, b1, ap, 0, 0, 0);
            af = __builtin_amdgcn_mfma_f32_16x16x32_bf16(a2, b2, af, 0, 0, 0);
        }
        const int sb = 16 * si + 4 * fq, t = 16 * ti + fr;
        float v[4];
#pragma unroll
        for (int j = 0; j < 4; ++j) v[j] = (sb + j <= t) ? ap[j] : af[j];
        u32x2 w; w.x = cvt_pk(v[0], v[1]); w.y = cvt_pk(v[2], v[3]);
        *(u32x2*)(ATT + (size_t)id * 4096 + t * 64 + sb) = w;
    }
    __syncthreads();
}

__device__ __forceinline__ s16x4 lds_tr(LAS unsigned char* p) { return __builtin_bit_cast(s16x4, __builtin_amdgcn_ds_read_tr16_b64_v4i16((LAS s16x4*)p)); }
__device__ __forceinline__ bf16x8 cat8(s16x4 lo, s16x4 hi) { bf16x8 r; r[0] = lo[0]; r[1] = lo[1]; r[2] = lo[2]; r[3] = lo[3]; r[4] = hi[0]; r[5] = hi[1]; r[6] = hi[2]; r[7] = hi[3]; return r; }
__device__ __forceinline__ void sb_unit(const Params& P, LAS unsigned char* lds, int id, int tid) {
    const int b = id >> 8, hd = (id >> 5) & 7, qt = id & 31;
    const int wave = tid >> 6, lane = tid & 63, ql = lane & 31, hh = lane >> 5;
    const int q0 = qt * 256, qw = q0 + 32 * wave, t = qw + ql;
    LAS unsigned char* Ks = lds; LAS unsigned char* Vs = lds + 64 * 272; LAS int* flags = (LAS int*)(lds + 2 * 64 * 272);
    bf16_t* Zb = (bf16_t*)(P.ws + WS_Z1) + (size_t)b * SEQ * LDZ;
    bf16x8 qf[8];
#pragma unroll
    for (int kk = 0; kk < 8; ++kk) qf[kk] = *(const bf16x8*)(Zb + (size_t)t * LDZ + ZC_QB + hd * 128 + 16 * kk + 8 * hh);
    f32x16 oacc[4];
#pragma unroll
    for (int db = 0; db < 4; ++db)
#pragma unroll
        for (int i = 0; i < 16; ++i) oacc[db][i] = 0.f;
    float R = 0.f; int wdone = 0;
    __syncthreads();
    if (lane == 0) flags[wave] = 0;
    const int i16 = lane & 15, blk = (lane >> 4) & 1;
    const float c2 = 0.08838834764831845f * 1.4426950408889634f;
    u32x4 kst[2], vst[2];
    { const int key0 = 64 * (4 * qt + 3);
#pragma unroll
      for (int i = 0; i < 2; ++i) { const int ch = tid + 512 * i, row = ch >> 4, cc = ch & 15; const bf16_t* src = Zb + (size_t)(key0 + row) * LDZ + hd * 128 + cc * 8;
          kst[i] = *(const u32x4*)(src + ZC_KB); vst[i] = *(const u32x4*)(src + ZC_VB); } }
    for (int kt = 4 * qt + 3; kt >= 0; --kt) {
        __syncthreads();
        int alld = 1;
#pragma unroll
        for (int w = 0; w < 8; ++w) alld &= flags[w];
        if (alld) break;
        const int key0 = 64 * kt;
#pragma unroll
        for (int i = 0; i < 2; ++i) { const int ch = tid + 512 * i, row = ch >> 4, cc = ch & 15;
            *(LAS u32x4*)(Ks + row * 272 + cc * 16) = kst[i]; *(LAS u32x4*)(Vs + row * 272 + cc * 16) = vst[i]; }
        if (kt > 0) {
#pragma unroll
            for (int i = 0; i < 2; ++i) { const int ch = tid + 512 * i, row = ch >> 4, cc = ch & 15; const bf16_t* src = Zb + (size_t)(key0 - 64 + row) * LDZ + hd * 128 + cc * 8;
                kst[i] = *(const u32x4*)(src + ZC_KB); vst[i] = *(const u32x4*)(src + ZC_VB); } }
        __syncthreads();
        if (!wdone && key0 <= qw + 30) {
#pragma unroll
            for (int kb = 1; kb >= 0; --kb) {
                const int kbase = key0 + 32 * kb;
                if (kbase > qw + 30) continue;
                f32x16 sacc;
#pragma unroll
                for (int i = 0; i < 16; ++i) sacc[i] = 0.f;
#pragma unroll
                for (int kk = 0; kk < 8; ++kk) { const bf16x8 a = *(const LAS bf16x8*)(Ks + (32 * kb + ql) * 272 + (16 * kk + 8 * hh) * 2);
                    sacc = __builtin_amdgcn_mfma_f32_32x32x16_bf16(a, qf[kk], sacc, 0, 0, 0); }
                float L[16], zl[16];
#pragma unroll
                for (int i = 0; i < 16; ++i) { const int key = kbase + 8 * (i >> 2) + 4 * hh + (i & 3); const bool valid = key < t;
                    const float z2 = sacc[i] * c2; const float sp = fmaxf(z2, 0.f) + flog2(1.0f + fexp2(-fabsf(z2)));
                    const float l = valid ? -sp : 0.f; L[i] = l; zl[i] = valid ? (z2 + l) : -1.0e30f; }
                float Pg[4], Qg[4], Tg[4];
#pragma unroll
                for (int g = 0; g < 4; ++g) { Pg[g] = (L[4 * g] + L[4 * g + 1]) + (L[4 * g + 2] + L[4 * g + 3]); Qg[g] = __shfl_xor(Pg[g], 32); }
                Tg[3] = 0.f; Tg[2] = Pg[3] + Qg[3]; Tg[1] = Tg[2] + (Pg[2] + Qg[2]); Tg[0] = Tg[1] + (Pg[1] + Qg[1]);
                const float total = Tg[0] + (Pg[0] + Qg[0]);
                float w[16];
#pragma unroll
                for (int g = 0; g < 4; ++g) { float e = R + Tg[g] + (hh == 0 ? Qg[g] : 0.f);
                    w[4 * g + 3] = fexp2(zl[4 * g + 3] + e); e += L[4 * g + 3];
                    w[4 * g + 2] = fexp2(zl[4 * g + 2] + e); e += L[4 * g + 2];
                    w[4 * g + 1] = fexp2(zl[4 * g + 1] + e); e += L[4 * g + 1];
                    w[4 * g + 0] = fexp2(zl[4 * g + 0] + e); }
                R += total;
                bf16x8 pa[2];
#pragma unroll
                for (int gp = 0; gp < 2; ++gp) { u32x4 pw; pw.x = cvt_pk(w[8 * gp], w[8 * gp + 1]); pw.y = cvt_pk(w[8 * gp + 2], w[8 * gp + 3]); pw.z = cvt_pk(w[8 * gp + 4], w[8 * gp + 5]); pw.w = cvt_pk(w[8 * gp + 6], w[8 * gp + 7]);
                    pa[gp] = __builtin_bit_cast(bf16x8, pw); }
#pragma unroll
                for (int gp = 0; gp < 2; ++gp)
#pragma unroll
                    for (int db = 0; db < 4; ++db) {
                        LAS unsigned char* vp = Vs + (32 * kb + 16 * gp + 4 * hh + (i16 >> 2)) * 272 + (32 * db + 16 * blk + 4 * (i16 & 3)) * 2;
                        const s16x4 lo = lds_tr(vp), hi = lds_tr(vp + 8 * 272);
                        oacc[db] = __builtin_amdgcn_mfma_f32_32x32x16_bf16(pa[gp], cat8(lo, hi), oacc[db], 0, 0, 0);
                    }
            }
            wdone = __all(R < -151.0f) ? 1 : 0;
        }
        if (lane == 0) flags[wave] = wdone;
    }
#pragma unroll
    for (int db = 0; db < 4; ++db)
#pragma unroll
        for (int i = 0; i < 16; ++i) { const int qr = qw + (i & 3) + 8 * (i >> 2) + 4 * hh;
            Zb[(size_t)qr * LDZ + ZC_OB + hd * 128 + 32 * db + ql] = f2bf(oacc[db][i]); }
}

__device__ __forceinline__ void gla_scan_unit(const Params& P, LAS unsigned char* lds, int unit, int wave, int lane) {
    const int b = unit >> 6, h = (unit >> 4) & 3, sl = unit & 15;
    const int fr = lane & 15, fq = lane >> 4, tw = wave;
    LAS unsigned char* vl = lds + wave * 2048;
    bf16_t* Zb = (bf16_t*)(P.ws + WS_Z1) + (size_t)b * SEQ * LDZ;
    const float* DEC = (const float*)(P.ws + WS_DEC);
    const bf16_t* ATT = (const bf16_t*)(P.ws + WS_ATTN);
    float* SSA = (float*)(P.ws + WS_SSA);
    f32x4 S[8];
#pragma unroll
    for (int mt = 0; mt < 8; ++mt) S[mt] = (f32x4){0.f, 0.f, 0.f, 0.f};
    u32x4 vr0, vr1; bf16x8 aa[2][2], qa[2][4], ka[8][2]; f32x4 dcr[8];
#define SCAN_LOAD(cc) do { const int tk = (cc) * 64; const size_t idn = ((size_t)b * 128 + (cc)) * 4 + h; \
        const u32x4* vp_ = (const u32x4*)(Zb + (size_t)(tk + lane) * LDZ + ZC_VA + h * 256 + sl * 16); vr0 = vp_[0]; vr1 = vp_[1]; \
        _Pragma("unroll") for (int mt = 0; mt < 8; ++mt) dcr[mt] = *(const f32x4*)(DEC + idn * 128 + 16 * mt + 4 * fq); \
        _Pragma("unroll") for (int tt = 0; tt < 2; ++tt) { _Pragma("unroll") for (int ks = 0; ks < 2; ++ks) aa[tt][ks] = *(const bf16x8*)(ATT + idn * 4096 + (32 * tw + 16 * tt + fr) * 64 + 32 * ks + 8 * fq); \
        _Pragma("unroll") for (int kq = 0; kq < 4; ++kq) qa[tt][kq] = *(const bf16x8*)(Zb + (size_t)(tk + 32 * tw + 16 * tt + fr) * LDZ + ZC_QA + h * 128 + 32 * kq + 8 * fq); } \
        _Pragma("unroll") for (int mt = 0; mt < 8; ++mt) _Pragma("unroll") for (int ks = 0; ks < 2; ++ks) { const int dk = 16 * mt + fr; \
            ka[mt][ks] = *(const bf16x8*)(Zb + (size_t)(tk + (dk >> 1)) * LDZ + ZC_KA + h * 128 + (dk & 1) * 64 + 32 * ks + 8 * fq); } } while (0)
    SCAN_LOAD(0);
    for (int c = 0; c < 128; ++c) {
        const size_t id = ((size_t)b * 128 + c) * 4 + h;
        if (wave == 0 && lane == 0) *(volatile LAS int*)(lds + 16384) = c;
#if SCAN_DIRECT_V == 1
        bf16x8 bv[2];
#pragma unroll
        for (int ks = 0; ks < 2; ++ks)
#pragma unroll
            for (int j = 0; j < 8; ++j) bv[ks][j] = (short)Zb[(size_t)(c * 64 + 32 * ks + 8 * fq + j) * LDZ + ZC_VA + h * 256 + sl * 16 + fr];
#else
        *(LAS u32x4*)(vl + lane * 32) = vr0; *(LAS u32x4*)(vl + lane * 32 + 16) = vr1;
        asm volatile("s_waitcnt lgkmcnt(0)" ::: "memory");
        bf16x8 bv[2];
#pragma unroll
#if SCAN_DIRECT_V == 2
        for (int ks = 0; ks < 2; ++ks)
#pragma unroll
            for (int j = 0; j < 8; ++j) bv[ks][j] = *(const LAS short*)(vl + (32 * ks + 8 * fq + j) * 32 + fr * 2);
#else
        for (int ks = 0; ks < 2; ++ks) { LAS unsigned char* vp = vl + (32 * ks + 8 * fq + (fr >> 2)) * 32 + (fr & 3) * 8;
            const s16x4 lo = lds_tr(vp), hi = lds_tr(vp + 4 * 32); bv[ks] = cat8(lo, hi); }
#endif
        asm volatile("s_waitcnt lgkmcnt(0)" ::: "memory");
#endif
        f32x4 o[2]; bf16x8 bs[4];
#pragma unroll
        for (int kq = 0; kq < 4; ++kq) { u32x4 sw; sw.x = cvt_pk(S[2 * kq][0], S[2 * kq][1]); sw.y = cvt_pk(S[2 * kq][2], S[2 * kq][3]); sw.z = cvt_pk(S[2 * kq + 1][0], S[2 * kq + 1][1]); sw.w = cvt_pk(S[2 * kq + 1][2], S[2 * kq + 1][3]); bs[kq] = __builtin_bit_cast(bf16x8, sw); }
#pragma unroll
        for (int tt = 0; tt < 2; ++tt) { o[tt] = (f32x4){0.f, 0.f, 0.f, 0.f};
            o[tt] = __builtin_amdgcn_mfma_f32_16x16x32_bf16(aa[tt][0], bv[0], o[tt], 0, 0, 0);
            o[tt] = __builtin_amdgcn_mfma_f32_16x16x32_bf16(aa[tt][1], bv[1], o[tt], 0, 0, 0);
#pragma unroll
            for (int kq = 0; kq < 4; ++kq) o[tt] = __builtin_amdgcn_mfma_f32_16x16x32_bf16(qa[tt][kq], bs[kq], o[tt], 0, 0, 0); }
#pragma unroll
        for (int mt = 0; mt < 8; ++mt) {
            S[mt] = S[mt] * dcr[mt];
            S[mt] = __builtin_amdgcn_mfma_f32_16x16x32_bf16(ka[mt][0], bv[0], S[mt], 0, 0, 0);
            S[mt] = __builtin_amdgcn_mfma_f32_16x16x32_bf16(ka[mt][1], bv[1], S[mt], 0, 0, 0); }
        const int cn = (c + 1) & 127;
        SCAN_LOAD(cn);
#pragma unroll
        for (int tt = 0; tt < 2; ++tt)
#pragma unroll
        for (int j = 0; j < 4; ++j) {
            const size_t tok = (size_t)c * 64 + 32 * tw + 16 * tt + 4 * fq + j;
            Zb[tok * LDZ + ZC_OA + h * 256 + sl * 16 + fr] = f2bf(o[tt][j]);
            float q = o[tt][j] * o[tt][j];
            q += __shfl_xor(q, 1); q += __shfl_xor(q, 2); q += __shfl_xor(q, 4); q += __shfl_xor(q, 8);
            if (fr == 0) SSA[((size_t)b * SEQ + tok) * 64 + h * 16 + sl] = q;
        }
    }
#undef SCAN_LOAD
}


constexpr int SC_KT = 0, SC_QA = 16384, SC_AA = 32768, SC_V = 40960, SC_DEC = 43008, SC_SLOT = 44032, SC_BASE = 0;
__device__ __forceinline__ void gla_scan_unit2(const Params& P, LAS unsigned char* lds, int unit, int wave, int lane) {
    const int b = unit >> 6, h = (unit >> 4) & 3, sl = unit & 15;
    const int fr = lane & 15, fq = lane >> 4, tw = wave;
    bf16_t* Zb = (bf16_t*)(P.ws + WS_Z1) + (size_t)b * SEQ * LDZ;
    const float* DEC = (const float*)(P.ws + WS_DEC);
    const bf16_t* ATT = (const bf16_t*)(P.ws + WS_ATTN);
    float* SSA = (float*)(P.ws + WS_SSA);
    LAS unsigned char* ring = lds + SC_BASE;
    if (wave == 4) {
        u32x4 r[2][19];
#define LOADA(cc, R) do { const int tk = (cc) * 64; const size_t idn = ((size_t)b * 128 + (cc)) * 4 + h; \
            _Pragma("unroll") for (int i = 0; i < 16; ++i) { const int mt = i >> 1, ks = i & 1, dk = 16 * mt + fr; r[R][i] = *(const u32x4*)(Zb + (size_t)(tk + (dk >> 1)) * LDZ + ZC_KA + h * 128 + (dk & 1) * 64 + 32 * ks + 8 * fq); } \
            { const u32x4* vp_ = (const u32x4*)(Zb + (size_t)(tk + lane) * LDZ + ZC_VA + h * 256 + sl * 16); r[R][16] = vp_[0]; r[R][17] = vp_[1]; } \
            r[R][18] = *(const u32x4*)(DEC + idn * 128 + 4 * (lane & 31)); } while (0)
#define STOREA(slot, R) do { LAS unsigned char* s_ = ring + (slot) * SC_SLOT; \
            _Pragma("unroll") for (int i = 0; i < 16; ++i) *(LAS u32x4*)(s_ + SC_KT + i * 1024 + lane * 16) = r[R][i]; \
            *(LAS u32x4*)(s_ + SC_V + lane * 32) = r[R][16]; *(LAS u32x4*)(s_ + SC_V + lane * 32 + 16) = r[R][17]; \
            if (lane < 32) *(LAS u32x4*)(s_ + SC_DEC + lane * 16) = r[R][18]; } while (0)
        LOADA(0, 0); STOREA(0, 0); LOADA(1, 0); LOADA(2, 1);
        __syncthreads();
        for (int c = 0; c < 128; c += 2) { STOREA(1, 0); LOADA((c + 3) & 127, 0); __syncthreads();
                                            STOREA(0, 1); LOADA((c + 4) & 127, 1); __syncthreads(); }
#undef LOADA
#undef STOREA
        return;
    }
    if (wave == 5) {
        u32x4 r[2][24];
#define LOADB(cc, R) do { const int tk = (cc) * 64; const size_t idn = ((size_t)b * 128 + (cc)) * 4 + h; \
            _Pragma("unroll") for (int i = 0; i < 16; ++i) { const int t4 = i >> 2, kq = i & 3; r[R][i] = *(const u32x4*)(Zb + (size_t)(tk + 16 * t4 + fr) * LDZ + ZC_QA + h * 128 + 32 * kq + 8 * fq); } \
            _Pragma("unroll") for (int i = 0; i < 8; ++i) { const int t4 = i >> 1, ks = i & 1; r[R][16 + i] = *(const u32x4*)(ATT + idn * 4096 + (16 * t4 + fr) * 64 + 32 * ks + 8 * fq); } } while (0)
#define STOREB(slot, R) do { LAS unsigned char* s_ = ring + (slot) * SC_SLOT; \
            _Pragma("unroll") for (int i = 0; i < 16; ++i) *(LAS u32x4*)(s_ + SC_QA + i * 1024 + lane * 16) = r[R][i]; \
            _Pragma("unroll") for (int i = 0; i < 8; ++i) *(LAS u32x4*)(s_ + SC_AA + i * 1024 + lane * 16) = r[R][16 + i]; } while (0)
        LOADB(0, 0); STOREB(0, 0); LOADB(1, 0); LOADB(2, 1);
        __syncthreads();
        for (int c = 0; c < 128; c += 2) { STOREB(1, 0); LOADB((c + 3) & 127, 0); __syncthreads();
                                            STOREB(0, 1); LOADB((c + 4) & 127, 1); __syncthreads(); }
#undef LOADB
#undef STOREB
        return;
    }
    if (wave >= 2) {
        __syncthreads();
        for (int c = 0; c < 128; ++c) __syncthreads();
        return;
    }
    f32x4 S[8];
#pragma unroll
    for (int mt = 0; mt < 8; ++mt) S[mt] = (f32x4){0.f, 0.f, 0.f, 0.f};
    __syncthreads();
    for (int c = 0; c < 128; ++c) {
        const LAS unsigned char* s_ = ring + (c & 1) * SC_SLOT;
        bf16x8 bv[2];
#pragma unroll
        for (int ks = 0; ks < 2; ++ks)
#pragma unroll
            for (int j = 0; j < 8; ++j) bv[ks][j] = *(const LAS short*)(s_ + SC_V + (32 * ks + 8 * fq + j) * 32 + fr * 2);
        f32x4 o[2]; bf16x8 bs[4];
#pragma unroll
        for (int kq = 0; kq < 4; ++kq) { u32x4 sw; sw.x = cvt_pk(S[2 * kq][0], S[2 * kq][1]); sw.y = cvt_pk(S[2 * kq][2], S[2 * kq][3]); sw.z = cvt_pk(S[2 * kq + 1][0], S[2 * kq + 1][1]); sw.w = cvt_pk(S[2 * kq + 1][2], S[2 * kq + 1][3]); bs[kq] = __builtin_bit_cast(bf16x8, sw); }
#pragma unroll
        for (int tt = 0; tt < 2; ++tt) { const int t4 = 2 * tw + tt; o[tt] = (f32x4){0.f, 0.f, 0.f, 0.f};
#pragma unroll
            for (int ks = 0; ks < 2; ++ks) { const bf16x8 a = *(const LAS bf16x8*)(s_ + SC_AA + (t4 * 2 + ks) * 1024 + lane * 16); o[tt] = __builtin_amdgcn_mfma_f32_16x16x32_bf16(a, bv[ks], o[tt], 0, 0, 0); }
#pragma unroll
            for (int kq = 0; kq < 4; ++kq) { const bf16x8 a = *(const LAS bf16x8*)(s_ + SC_QA + (t4 * 4 + kq) * 1024 + lane * 16); o[tt] = __builtin_amdgcn_mfma_f32_16x16x32_bf16(a, bs[kq], o[tt], 0, 0, 0); } }
#pragma unroll
        for (int mt = 0; mt < 8; ++mt) { const f32x4 dc = *(const LAS f32x4*)(s_ + SC_DEC + (16 * mt + 4 * fq) * 4);
            S[mt] = S[mt] * dc;
#pragma unroll
            for (int ks = 0; ks < 2; ++ks) { const bf16x8 a = *(const LAS bf16x8*)(s_ + SC_KT + (mt * 2 + ks) * 1024 + lane * 16); S[mt] = __builtin_amdgcn_mfma_f32_16x16x32_bf16(a, bv[ks], S[mt], 0, 0, 0); } }
#pragma unroll
        for (int tt = 0; tt < 2; ++tt)
#pragma unroll
        for (int j = 0; j < 4; ++j) {
            const size_t tok = (size_t)c * 64 + 32 * tw + 16 * tt + 4 * fq + j;
            Zb[tok * LDZ + ZC_OA + h * 256 + sl * 16 + fr] = f2bf(o[tt][j]);
            float q = o[tt][j] * o[tt][j];
            q += __shfl_xor(q, 1); q += __shfl_xor(q, 2); q += __shfl_xor(q, 4); q += __shfl_xor(q, 8);
            if (fr == 0) SSA[((size_t)b * SEQ + tok) * 64 + h * 16 + sl] = q;
        }
        __syncthreads();
    }
}

__device__ __forceinline__ void gla_scan_prefetch(const Params& P, LAS unsigned char* lds, int unit, int lane) {
    const int b = unit >> 6, h = (unit >> 4) & 3, sl = unit & 15;
    const unsigned char* Zb = (const unsigned char*)((const bf16_t*)(P.ws + WS_Z1) + (size_t)b * SEQ * LDZ);
    const int L = sl * 64 + lane;
    float acc = 0.f;
    for (int pc = 0; pc < 128; pc += 2) {
        while (*(volatile LAS int*)(lds + 16384) + 10 < pc) __builtin_amdgcn_s_sleep(4);
#pragma unroll
        for (int k = 0; k < 2; ++k) { const int c = pc + k; const size_t id = ((size_t)b * 128 + c) * 4 + h; const unsigned char* p = nullptr;
            if (L < 128) p = Zb + ((size_t)c * 64 + (L >> 1)) * (LDZ * 2) + (ZC_KA + h * 128) * 2 + (L & 1) * 128;
            else if (L < 256) p = Zb + ((size_t)c * 64 + ((L - 128) >> 1)) * (LDZ * 2) + (ZC_QA + h * 128) * 2 + (L & 1) * 128;
            else if (L < 512) p = Zb + ((size_t)c * 64 + ((L - 256) >> 2)) * (LDZ * 2) + (ZC_VA + h * 256) * 2 + (L & 3) * 128;
            else if (L < 576) p = P.ws + WS_ATTN + id * 8192 + (size_t)(L - 512) * 128;
            else if (L < 580) p = P.ws + WS_DEC + id * 512 + (size_t)(L - 576) * 128;
            if (p) acc += *(const volatile float*)p; }
    }
    if (acc == 1.2345e-30f) *(volatile LAS float*)(lds + 16388) = acc;
}

__global__ void __launch_bounds__(512, 2) fwd_kernel(Params P) {
    extern __shared__ __attribute__((aligned(16))) unsigned char lds_raw[];
#if N_LAUNCHES == 1
    cg::grid_group grid = cg::this_grid();
#endif
    LAS unsigned char* lds = (LAS unsigned char*)lds_raw;
    volatile LAS unsigned* MISC = (volatile LAS unsigned*)(lds + 131072 + 320);
    if (threadIdx.x < 32) MISC[threadIdx.x] = 0u;
    __syncthreads();
#if !USE_CG_SYNC
    XcdBarrier bar = xcd_barrier_post((unsigned*)P.ws + 4096, MISC + 8);
    if (P.ws == nullptr) grid.sync();
#endif
#if N_LAUNCHES != 1
#define GRID_SYNC() do { } while (0)
#elif USE_CG_SYNC
#define GRID_SYNC() do { asm volatile("s_waitcnt vmcnt(0)" ::: "memory"); grid.sync(); __builtin_amdgcn_fence(__ATOMIC_ACQUIRE, "agent"); asm volatile("s_waitcnt vmcnt(0)" ::: "memory"); } while (0)
#else
#if SYS_INV
#define GRID_SYNC() do { asm volatile("s_waitcnt vmcnt(0)\n\tbuffer_wbl2 sc0 sc1\n\ts_waitcnt vmcnt(0)" ::: "memory"); xcd_barrier(bar); asm volatile("buffer_inv sc0 sc1\n\ts_waitcnt vmcnt(0)" ::: "memory"); __syncthreads(); } while (0)
#else
#define GRID_SYNC() xcd_barrier(bar)
#endif
#endif
    const int G = gridDim.x;
    unsigned char* ws = P.ws;
    bf16_t* Z = (bf16_t*)(ws + WS_Z1);
    bf16_t* H = (bf16_t*)(ws + WS_H);

#if N_LAUNCHES == 1
#define IN(k) true
#if DIAG == 20
#define STAMP(k) do { if (blockIdx.x == 0 && threadIdx.x == 0) ((unsigned long long*)(P.ws + 500 * MiB + 8192))[k] = __builtin_amdgcn_s_memrealtime(); } while (0)
#else
#define STAMP(k) do { } while (0)
#endif
#else
#define IN(k) (P.ph_lo <= (k) && (k) < P.ph_hi)
#endif
#define BOTH(k) (IN(k) && IN((k) + 1))
    STAMP(0);
    if (IN(0)) {
#if DIAG == 4
    { const int tid = fresh_tid(); for (size_t i = (size_t)blockIdx.x * 512 + tid; i < (size_t)NTOK * 1024; i += (size_t)G * 512) P.out[i] = 0.f; }
#endif
    phase0(P, lds, fresh_tid(), G);
    }
    if (BOTH(0)) GRID_SYNC();
    STAMP(1);
    if (IN(1)) {
#if DIAG == 9
    { const int tid = fresh_tid(); const bf16_t* w0 = (const bf16_t*)(ws + WS_WG); const bf16_t* w1 = (const bf16_t*)(ws + WS_WS); const bf16_t* w2 = (const bf16_t*)(ws + WS_WO); const bf16_t* w3 = (const bf16_t*)(ws + WS_WPG); const bf16_t* w4 = (const bf16_t*)(ws + WS_WPE);
      const bf16_t* pb = (const bf16_t*)(ws + WS_PB);
      for (size_t i = (size_t)blockIdx.x * 512 + tid; i < (size_t)NTOK * 1024; i += (size_t)G * 512) { const size_t j = i & 0xFFFFF;
          P.out[i] = bf2f(((const bf16_t*)(ws + WS_W4T))[i & 0x3FFFFF]) + 2.f * bf2f(((const bf16_t*)(ws + WS_W1T))[i % (5376u * 1024u)]) + 3.f * bf2f(H[i]); }
      return; }
#endif
    {
        pg8::Gemm g{H, (const bf16_t*)(ws + WS_W1T), H, (const bf16_t*)(ws + WS_W1T), NTOK, 5376, 1024, 1024};
        pg8::StaticOrder S; S.init(NTOK, 5376, G, (int)blockIdx.x);
        EpiZ1 E{Z, (float*)(ws + WS_LR)};
        pg8::gemm_phase<EpiZ1, pg8::StaticOrder, true, true>(lds, g, S, E);
    }
    }
    if (BOTH(1)) GRID_SYNC();
    STAMP(2);
    if (IN(2)) {
#if DIAG == 2
    {
        const int tid = fresh_tid();
        for (size_t i = (size_t)blockIdx.x * 512 + tid; i < (size_t)NTOK * 1024; i += (size_t)G * 512) { const size_t r = i >> 10, c = i & 1023;
            P.out[i] = bf2f(Z[r * LDZ + c + 2048]) + ((const float*)(ws + WS_LR))[r * 16 + (c & 15)]; }
        return;
    }
#endif
#if DIAG == 14
    {
        const int tid = fresh_tid(); const size_t r0 = (size_t)blockIdx.x * 128 + (tid & 127); const int grp = tid >> 7;
        if (blockIdx.x == 0 && tid == 0) { *(unsigned*)(ws + 500 * MiB) = 0u; *((unsigned*)(ws + 500 * MiB) + 64) = 0u; }
        float ss = 0.f; for (int k = 0; k < 1024; ++k) { const float v = P.x[r0 * 1024 + k]; ss += v * v; }
        const float rstd = rsqrtf(ss / 1024.f + EPS);
        const int cols[12] = {7, 300, 777, 1500, 2100, 3000, 3500, 4100, 5000, 5121, 1023, 4607};
        int bad = 0;
#pragma unroll
        for (int j = 0; j < 3; ++j) { const int n = cols[grp * 3 + j]; const int col = n < 2048 ? n : (n < 5120 ? n + 1040 : 2048 + (n - 5120)); float s = 0.f;
            for (int k = 0; k < 1024; ++k) s += P.x[r0 * 1024 + k] * rstd * P.g_mix[k] * P.w_in[(size_t)k * 9232 + col];
            const float g = n < 5120 ? bf2f(Z[r0 * LDZ + n]) : ((const float*)(ws + WS_LR))[r0 * 16 + (n - 5120)];
            if (fabsf(s - g) > 0.05f) ++bad; }
        if (bad) { atomicAdd((unsigned*)(ws + 500 * MiB), (unsigned)bad); atomicMax((unsigned*)(ws + 500 * MiB) + 64, (unsigned)(r0 & 255) + 1u); }
        __threadfence(); __syncthreads();
    }
    GRID_SYNC();
    { const int tid = fresh_tid(); const float cst = (float)__hip_atomic_load((const unsigned*)(ws + 500 * MiB) + DIAG13_WHICH * 64, __ATOMIC_RELAXED, __HIP_MEMORY_SCOPE_AGENT);
      for (size_t i = (size_t)blockIdx.x * 512 + tid; i < (size_t)NTOK * 1024; i += (size_t)G * 512) P.out[i] = cst; }
    return;
#endif
#if DIAG == 15
    if (blockIdx.x == 0) {
        const int tid = fresh_tid(); const int bq = DIAG_B, hq = DIAG_H;
        float* EXP = (float*)(ws + 470 * MiB); float* ST = (float*)(ws + 480 * MiB); float* BB = ST + 128 * 256; float* AT = BB + 64 * 128;
        const float* LRp = (const float*)(ws + WS_LR); const float sc = 0.08838834764831845f;
        if (tid == 0) { *(unsigned*)(ws + 500 * MiB) = 0u; *((unsigned*)(ws + 500 * MiB) + 64) = 0u; }
        for (int i = tid; i < 128 * 256; i += 512) ST[i] = 0.f;
        __threadfence(); __syncthreads();
        for (int c = 0; c < 128; ++c) {
            const size_t tk = (size_t)bq * SEQ + (size_t)c * 64;
            if (tid < 128) { const int d = tid; float run = 0.f;
                for (int t = 0; t < 64; ++t) { float pre = P.b_alpha[hq * 128 + d]; for (int r = 0; r < 16; ++r) pre += LRp[(tk + t) * 16 + r] * P.w_alpha[r * 512 + hq * 128 + d];
                    run += (fminf(pre, 0.f) - log1pf(expf(-fabsf(pre)))) / 16.f; BB[t * 128 + d] = run; } }
            __threadfence(); __syncthreads();
            for (int i = tid; i < 64 * 64; i += 512) { const int t = i >> 6, s = i & 63; float a = 0.f;
                for (int d = 0; d < 128; ++d) a += bf2f(Z[(tk + t) * LDZ + ZC_QA + hq * 128 + d]) * sc * bf2f(Z[(tk + s) * LDZ + ZC_KA + hq * 128 + d]) * expf(-fabsf(BB[t * 128 + d] - BB[s * 128 + d]));
                AT[i] = a; }
            __threadfence(); __syncthreads();
            for (int i = tid; i < 64 * 256; i += 512) { const int t = i >> 8, dv = i & 255; float o = 0.f;
                for (int s = 0; s < 64; ++s) o += AT[t * 64 + s] * bf2f(Z[(tk + s) * LDZ + ZC_VA + hq * 256 + dv]);
                for (int d = 0; d < 128; ++d) o += bf2f(Z[(tk + t) * LDZ + ZC_QA + hq * 128 + d]) * sc * expf(BB[t * 128 + d]) * ST[d * 256 + dv];
                EXP[((size_t)c * 64 + t) * 256 + dv] = o; }
            __threadfence(); __syncthreads();
            for (int i = tid; i < 128 * 256; i += 512) { const int d = i >> 8, dv = i & 255; float s_ = ST[i] * expf(BB[63 * 128 + d]);
                for (int s = 0; s < 64; ++s) s_ += bf2f(Z[(tk + s) * LDZ + ZC_KA + hq * 128 + d]) * expf(BB[63 * 128 + d] - BB[s * 128 + d]) * bf2f(Z[(tk + s) * LDZ + ZC_VA + hq * 256 + dv]);
                ST[i] = s_; }
            __threadfence(); __syncthreads();
        }
    }
    GRID_SYNC();
#endif
#if DIAG == 12
    {
        const int tid = fresh_tid(); float* EXP = (float*)(ws + 470 * MiB); const size_t t = (size_t)blockIdx.x * 128 + (tid & 127); const int d0 = (tid >> 7) * 32; const int hd = DIAG_HD;
        if (blockIdx.x == 0 && tid == 0) { *(unsigned*)(ws + 500 * MiB) = 0u; *((unsigned*)(ws + 500 * MiB) + 64) = 0u; }
        const long sb0 = (long)(t / SEQ) * SEQ;
        float o[32]; for (int e = 0; e < 32; ++e) o[e] = 0.f; float after = 0.f;
        for (long s = (long)t - 1; s >= sb0; --s) { float z = 0.f; for (int d = 0; d < 128; ++d) z += bf2f(Z[t * LDZ + ZC_QB + hd * 128 + d]) * bf2f(Z[(size_t)s * LDZ + ZC_KB + hd * 128 + d]);
            z *= 0.08838834764831845f;
            const float sp = log1pf(expf(-fabsf(z))); const float lsig = fminf(z, 0.f) - sp, l1m = fminf(-z, 0.f) - sp;
            const float w = expf(lsig + after); after += l1m;
            for (int e = 0; e < 32; ++e) o[e] += w * bf2f(Z[(size_t)s * LDZ + ZC_VB + hd * 128 + d0 + e]);
            if (after < -120.f) break; }
        for (int e = 0; e < 32; ++e) EXP[t * 128 + d0 + e] = o[e];
        __threadfence(); __syncthreads();
    }
    GRID_SYNC();
#endif
#if DIAG == 11
    if (blockIdx.x == 0) {
        const int tid = fresh_tid();
        float* EXP = (float*)(ws + 460 * MiB); float* BB = EXP + 128 * 256; float* ST = BB + 128 * 128;
        const float* LRp = (const float*)(ws + WS_LR);
        for (int i = tid; i < 128 * 128; i += 512) { const int t = i >> 7, d = i & 127; float pre = P.b_alpha[d];
            for (int r = 0; r < 16; ++r) pre += LRp[t * 16 + r] * P.w_alpha[r * 512 + d];
            const float ls = fminf(pre, 0.f) - log1pf(expf(-fabsf(pre))); BB[i] = ls / 16.f; }
        __threadfence(); __syncthreads();
        if (tid < 256) { const int d = tid & 127, ch = tid >> 7; float run = 0.f; for (int t = 0; t < 64; ++t) { run += BB[(ch * 64 + t) * 128 + d]; BB[(ch * 64 + t) * 128 + d] = run; } }
        __threadfence(); __syncthreads();
        const float sc = 0.08838834764831845f;
        for (int i = tid; i < 64 * 256; i += 512) { const int t = i >> 8, dv = i & 255; float o = 0.f;
            for (int s = 0; s < 64; ++s) { float a = 0.f; for (int d = 0; d < 128; ++d) { const float q = bf2f(Z[(size_t)t * LDZ + d]) * sc, k = bf2f(Z[(size_t)s * LDZ + 512 + d]);
                    a += q * k * expf(-fabsf(BB[t * 128 + d] - BB[s * 128 + d])); }
                o += a * bf2f(Z[(size_t)s * LDZ + 1024 + dv]); }
            EXP[t * 256 + dv] = o; }
        for (int i = tid; i < 128 * 256; i += 512) { const int d = i >> 8, dv = i & 255; float s_ = 0.f;
            for (int s = 0; s < 64; ++s) s_ += bf2f(Z[(size_t)s * LDZ + 512 + d]) * expf(BB[63 * 128 + d] - BB[s * 128 + d]) * bf2f(Z[(size_t)s * LDZ + 1024 + dv]);
            ST[i] = s_; }
        __threadfence(); __syncthreads();
        for (int i = tid; i < 64 * 256; i += 512) { const int t = 64 + (i >> 8), dv = i & 255; float o = 0.f;
            for (int s = 64; s < 128; ++s) { float a = 0.f; for (int d = 0; d < 128; ++d) { const float q = bf2f(Z[(size_t)t * LDZ + d]) * sc, k = bf2f(Z[(size_t)s * LDZ + 512 + d]);
                    a += q * k * expf(-fabsf(BB[t * 128 + d] - BB[s * 128 + d])); }
                o += a * bf2f(Z[(size_t)s * LDZ + 1024 + dv]); }
            for (int d = 0; d < 128; ++d) o += bf2f(Z[(size_t)t * LDZ + d]) * sc * expf(BB[t * 128 + d]) * ST[d * 256 + dv];
            EXP[t * 256 + dv] = o; }
        __threadfence(); __syncthreads();
    }
    GRID_SYNC();
#endif
#if DIAG != 3 && DIAG != 4 && DIAG != 8 && DIAG != 5 && DIAG != 6
    { const int tid = fresh_tid(); for (int u = blockIdx.x; u < 1024; u += G) sb_unit(P, lds, (G == 256) ? ((u & 7) * 128 + (u >> 3)) : u, tid); }
    __syncthreads();
    { const int tid = fresh_tid();
      if (G == 256) { const int x = blockIdx.x & 7, j = blockIdx.x >> 3;
          for (int kk = 0; kk < 8; ++kk) { const int li = j * 8 + kk, c = li >> 1, h = 2 * (x & 1) + (li & 1), b = x >> 1; gla_prep_unit(P, lds, (b * 128 + c) * 4 + h, tid); } }
      else for (int u = blockIdx.x; u < 2048; u += G) gla_prep_unit(P, lds, u, tid); }
    }
    if (BOTH(2)) GRID_SYNC();
    STAMP(3);
    if (IN(3)) {
#if DIAG == 10
    { const int tid = fresh_tid(); const bf16_t* ATTd = (const bf16_t*)(ws + WS_ATTN); const float* DECd = (const float*)(ws + WS_DEC);
      for (size_t i = (size_t)blockIdx.x * 512 + tid; i < (size_t)NTOK * 1024; i += (size_t)G * 512) { const size_t r = i >> 10, c = i & 1023;
          P.out[i] = bf2f(Z[r * LDZ + c]) + 2.f * bf2f(ATTd[i & 0x7FFFFF]) + 4.f * DECd[i & 0x3FFFF]; } return; }
#endif
    {
        const int tid = fresh_tid(); const int wave = __builtin_amdgcn_readfirstlane(tid >> 6), lane = tid & 63;
        for (int u = blockIdx.x; u < 256; u += G) gla_scan_unit2(P, lds, (G == 256) ? ((u & 7) * 32 + (u >> 3)) : u, wave, lane);
    }
#endif
    }
    if (BOTH(3)) GRID_SYNC();
    STAMP(4);
    if (IN(4)) {
#if DIAG == 7
    { const int tid = fresh_tid(); const float* SSAd = (const float*)(ws + WS_SSA);
      for (size_t i = (size_t)blockIdx.x * 512 + tid; i < (size_t)NTOK * 1024; i += (size_t)G * 512) { const size_t r = i >> 10, c = i & 1023;
#if DIAG7_SEL == 0
          P.out[i] = bf2f(Z[r * LDZ + ZC_OB + c]); } return; }
#elif DIAG7_SEL == 1
          P.out[i] = bf2f(Z[r * LDZ + ZC_OA + c]); } return; }
#else
          P.out[i] = SSAd[r * 64 + (c & 63)]; } return; }
#endif
#endif
#if DIAG == 13
    { const int tid = fresh_tid(); float* SC = (float*)(ws + 460 * MiB) + (size_t)blockIdx.x * 4096; const size_t r0 = (size_t)blockIdx.x * 128 + 37;
      if (blockIdx.x == 0 && tid == 0) { *(unsigned*)(ws + 500 * MiB) = 0u; *((unsigned*)(ws + 500 * MiB) + 64) = 0u; }
        for (int i = tid; i < 1024; i += 512) { SC[i] = bf2f(Z[r0 * LDZ + ZC_OA + i]); SC[1024 + i] = bf2f(Z[r0 * LDZ + ZC_OB + i]); }
        if (tid < 64) SC[2048 + tid] = ((const float*)(ws + WS_SSA))[r0 * 64 + tid];
        __threadfence(); __syncthreads(); }
    GRID_SYNC();
#endif
#if DIAG == 15
    {   const int tid = fresh_tid(); const float* EXP = (const float*)(ws + 470 * MiB); LAS float* red = (LAS float*)lds; float* PC = (float*)(ws + 500 * MiB + 4096);
        if (blockIdx.x < 128) { const int c = blockIdx.x; float se = 0.f, sr = 0.f;
            for (int i = tid; i < 64 * 256; i += 512) { const size_t t = (size_t)c * 64 + (i >> 8); const int dv = i & 255;
                const float e = EXP[t * 256 + dv], g = bf2f(Z[((size_t)DIAG_B * SEQ + t) * LDZ + ZC_OA + DIAG_H * 256 + dv]); se += (e - g) * (e - g); sr += e * e; }
            red[tid] = se; red[512 + tid] = sr; __syncthreads();
            if (tid == 0) { float a = 0.f, b = 0.f; for (int i = 0; i < 512; ++i) { a += red[i]; b += red[512 + i]; } PC[c] = sqrtf(a / b); }
        }
        __threadfence(); __syncthreads();
    }
    GRID_SYNC();
    { const int tid = fresh_tid(); const float* PC = (const float*)(ws + 500 * MiB + 4096); int cnt = 0;
      for (int c = 0; c < 128; ++c) { const float v = __hip_atomic_load(PC + c, __ATOMIC_RELAXED, __HIP_MEMORY_SCOPE_AGENT); if (v > 0.03f) ++cnt; }
      const float cst = (float)cnt;
      for (size_t i = (size_t)blockIdx.x * 512 + tid; i < (size_t)NTOK * 1024; i += (size_t)G * 512) P.out[i] = cst; }
    return;
#endif
#if DIAG == 12
    {   const int tid = fresh_tid(); const float* EXP = (const float*)(ws + 470 * MiB); int bad = 0; unsigned badrow = 0;
        for (size_t i = (size_t)blockIdx.x * 512 + tid; i < (size_t)NTOK * 128; i += (size_t)G * 512) { const size_t t = i >> 7; const int d = (int)(i & 127);
            const float e = EXP[i], g = bf2f(Z[t * LDZ + ZC_OB + DIAG_HD * 128 + d]); if (fabsf(e - g) > 0.05f) { ++bad; badrow = (unsigned)(t & 8191) + 1u; } }
        if (bad) { atomicAdd((unsigned*)(ws + 500 * MiB), (unsigned)bad); atomicMax((unsigned*)(ws + 500 * MiB) + 64, badrow); }
        __threadfence(); __syncthreads();
    }
    GRID_SYNC();
    { const int tid = fresh_tid(); const float cst = (float)__hip_atomic_load((const unsigned*)(ws + 500 * MiB) + DIAG13_WHICH * 64, __ATOMIC_RELAXED, __HIP_MEMORY_SCOPE_AGENT);
      for (size_t i = (size_t)blockIdx.x * 512 + tid; i < (size_t)NTOK * 1024; i += (size_t)G * 512) P.out[i] = cst; }
    return;
#endif
#if DIAG == 11
    {
        const int tid = fresh_tid(); const float* EXP = (const float*)(ws + 460 * MiB);
        LAS float* red = (LAS float*)lds;
        float md = 0.f, mx = 0.f;
        for (int i = tid; i < 128 * 256; i += 512) { const int t = i >> 8, dv = i & 255; const float e = EXP[i], g = bf2f(Z[(size_t)t * LDZ + ZC_OA + dv]); md = fmaxf(md, fabsf(e - g)); mx = fmaxf(mx, fabsf(e)); }
        red[tid] = md; red[512 + tid] = mx; __syncthreads();
        if (tid == 0) { float a = 0.f, b = 0.f; for (int i = 0; i < 512; ++i) { a = fmaxf(a, red[i]); b = fmaxf(b, red[512 + i]); } red[1024] = 1.f + 100.f * a / fmaxf(b, 1e-20f); }
        __syncthreads();
        const float cst = red[1024];
        for (size_t i = (size_t)blockIdx.x * 512 + tid; i < (size_t)NTOK * 1024; i += (size_t)G * 512) P.out[i] = cst;
        return;
    }
#endif
    {
        pg8::Gemm g{H, (const bf16_t*)(ws + WS_W4T), H, (const bf16_t*)(ws + WS_W4T), NTOK, 4096, 1024, 1024};
        pg8::StaticOrder S; S.init(NTOK, 4096, G, (int)blockIdx.x);
        EpiGates E{Z, (const float*)(ws + WS_SSA), P.g_gla, Z, (bf16_t*)(ws + (DIAG == 8 ? 448 : 416) * MiB)};
        pg8::gemm_phase<EpiGates, pg8::StaticOrder, true, true>(lds, g, S, E);
    }
    }
    if (BOTH(4)) GRID_SYNC();
    STAMP(5);
    if (IN(5)) {
#if DIAG == 8
    {
        const int tid = fresh_tid(); const bf16_t* SGX = (const bf16_t*)(ws + 448 * MiB);
        for (size_t i = (size_t)blockIdx.x * 512 + tid; i < (size_t)NTOK * 1024; i += (size_t)G * 512) P.out[i] = bf2f(SGX[i]);
        return;
    }
#endif
#if DIAG == 4
    {
        const int tid = fresh_tid();
        for (size_t i = (size_t)blockIdx.x * 512 + tid; i < (size_t)NTOK * 1024; i += (size_t)G * 512) { const size_t r = i >> 10, c = i & 1023;
            const unsigned sgw = __hip_atomic_load((const unsigned*)P.out + i, __ATOMIC_RELAXED, __HIP_MEMORY_SCOPE_AGENT);
#if DIAG4_SGONLY
            P.out[i] = bflo(sgw) + bfhi(sgw); }
#else
            P.out[i] = bf2f(Z[r * LDZ + ZC_OA + c]) + bf2f(Z[r * LDZ + ZC_OB + c]) + bflo(sgw) + bfhi(sgw); }
#endif
        return;
    }
#endif
#if DIAG == 6
    { const int tid = fresh_tid(); for (size_t i = (size_t)blockIdx.x * 512 + tid; i < (size_t)NTOK * 1024; i += (size_t)G * 512) { const size_t r = i >> 10, c = i & 1023; P.out[i] = bf2f(Z[r * LDZ + c]); } return; }
#endif
    {
        pg8::Gemm g{Z + ZC_OA, (const bf16_t*)(ws + WS_WG), Z + ZC_OB, (const bf16_t*)(ws + WS_WS), NTOK, 1024, 1024, LDZ};
        PairOrder S; S.init(NTOK, 1024, G, (int)blockIdx.x);
        EpiMerge E{Z + ZC_VA, Z};
        pg8::gemm_phase<EpiMerge, PairOrder, true, true>(lds, g, S, E);
    }
    }
    if (BOTH(5)) GRID_SYNC();
    STAMP(6);
    if (IN(6)) {
#if DIAG == 6
#endif
#if DIAG == 5
    { const int tid = fresh_tid(); for (size_t i = (size_t)blockIdx.x * 512 + tid; i < (size_t)NTOK * 1024; i += (size_t)G * 512) { const size_t r = i >> 10, c = i & 1023; P.out[i] = bf2f(Z[r * LDZ + ZC_VA + c]); } return; }
#endif
    {
        pg8::Gemm g{Z + ZC_VA, (const bf16_t*)(ws + WS_WO), Z + ZC_VA, (const bf16_t*)(ws + WS_WO), NTOK, 1024, 1024, LDZ};
        pg8::StaticOrder S; S.init(NTOK, 1024, G, (int)blockIdx.x);
        EpiX1 E{P.x, Z, (float*)(ws + WS_SS1)};
        pg8::gemm_phase<EpiX1, pg8::StaticOrder, true, true>(lds, g, S, E);
    }
    }
    if (BOTH(6)) GRID_SYNC();
    STAMP(7);
    if (IN(7)) {
    {
        pg8::Gemm g{(const bf16_t*)(ws + WS_PB), (const bf16_t*)(ws + WS_WPE), (const bf16_t*)(ws + WS_PB), (const bf16_t*)(ws + WS_WPE), NTOK, 1024, 256, 256};
        pg8::StaticOrder S; S.init(NTOK, 1024, G, (int)blockIdx.x);
        EpiPE E{Z};
        pg8::gemm_phase<EpiPE, pg8::StaticOrder, true, true>(lds, g, S, E);
    }
    {
        pg8::Gemm g{Z, (const bf16_t*)(ws + WS_WPG), Z, (const bf16_t*)(ws + WS_WPG), NTOK, 1024, 1024, LDZ};
        pg8::StaticOrder S; S.init(NTOK, 1024, G, (int)blockIdx.x);
        EpiX2 E{Z, (const float*)(ws + WS_SS1), (float*)(ws + WS_SS2)};
        pg8::gemm_phase<EpiX2, pg8::StaticOrder, true, true>(lds, g, S, E);
    }
    }
    if (BOTH(7)) GRID_SYNC();
    STAMP(8);
    if (IN(8)) {
    {
        const int tid = fresh_tid(); const int wave = tid >> 6, lane = tid & 63;
        const float* SS2 = (const float*)(ws + WS_SS2);
        for (int it = 0; it < (NTOK + G * 8 - 1) / (G * 8); ++it) {
            const int m = (G == 256) ? (4096 * (int)(blockIdx.x & 7) + 128 * (int)(blockIdx.x >> 3) + 16 * wave + it) : ((int)blockIdx.x * 8 + wave + it * G * 8);
            if (m >= NTOK) break;
            const f32x4* sp = (const f32x4*)(SS2 + (size_t)m * 16); const f32x4 a = sp[0], b = sp[1], c4 = sp[2], d = sp[3];
            const float s = ((a.x + a.y) + (a.z + a.w)) + ((b.x + b.y) + (b.z + b.w)) + ((c4.x + c4.y) + (c4.z + c4.w)) + ((d.x + d.y) + (d.z + d.w));
            const float rstd = rsqrtf(s * (1.f / 1024.f) + EPS);
            const f32x4* xi = (const f32x4*)(Z + (size_t)m * LDZ + 2048) + lane; f32x4* xr = (f32x4*)(P.out + (size_t)m * DM) + lane;
#pragma unroll
            for (int j = 0; j < 4; ++j) { const f32x4 g4 = ((const f32x4*)P.g_final)[64 * j + lane]; __builtin_nontemporal_store(xi[64 * j] * rstd * g4, &xr[64 * j]); }
        }
    }
    }
#if DIAG == 13
    GRID_SYNC();
    {
        const int tid = fresh_tid(); const size_t r0 = (size_t)blockIdx.x * 128 + 37; const float* SC = (const float*)(ws + 460 * MiB) + (size_t)blockIdx.x * 4096; float* T = (float*)(ws + 470 * MiB) + (size_t)blockIdx.x * 16384;
        float* hrow = T, *A1 = T + 1024, *A2 = T + 2048, *mg = T + 3072, *x1 = T + 4096, *uu = T + 5120, *x2 = T + 6144, *sm = T + 7168, *red = T + 9216;
        for (int i = tid; i < 1024; i += 512) hrow[i] = bf2f(H[r0 * 1024 + i]);
        __threadfence(); __syncthreads();
        for (int n = tid; n < 4096; n += 512) { const int col = (n < 1024) ? 2064 + n : (n < 2048 ? 6160 + (n - 1024) : 7184 + (n - 2048)); float s = 0.f;
            for (int k = 0; k < 1024; ++k) s += hrow[k] * P.w_in[(size_t)k * 9232 + col];
            if (n < 1024) { float ss = 0.f; for (int j = 0; j < 16; ++j) ss += SC[2048 + (n >> 8) * 16 + j]; const float rstd = rsqrtf(ss / 256.f + EPS);
                A1[n] = SC[n] * rstd * P.g_gla[n] * (s / (1.f + expf(-s))); }
            else if (n < 2048) A2[n - 1024] = SC[1024 + (n - 1024)] * (s / (1.f + expf(-s)));
            else sm[n - 2048] = 1.f / (1.f + expf(-s)); }
        __threadfence(); __syncthreads();
        for (int n = tid; n < 1024; n += 512) { float ya = 0.f, yb = 0.f; for (int k = 0; k < 1024; ++k) { ya += A1[k] * P.w_out_gla[(size_t)k * 1024 + n]; yb += A2[k] * P.w_out_sb[(size_t)k * 1024 + n]; }
            mg[n] = sm[n] * ya + sm[1024 + n] * yb; }
        __threadfence(); __syncthreads();
        for (int n = tid; n < 1024; n += 512) { float s = 0.f; for (int k = 0; k < 1024; ++k) s += mg[k] * P.w_out[(size_t)k * 1024 + n]; x1[n] = P.x[r0 * 1024 + n] + s; }
        __threadfence(); __syncthreads();
        if (tid == 0) { float ss = 0.f; for (int k = 0; k < 1024; ++k) ss += x1[k] * x1[k]; red[0] = rsqrtf(ss / 1024.f + EPS); }
        __threadfence(); __syncthreads();
        for (int n = tid; n < 1024; n += 512) uu[n] = x1[n] * red[0] * P.g_ple[n];
        __threadfence(); __syncthreads();
        for (int n = tid; n < 1024; n += 512) { float s = 0.f, pe = 0.f; for (int k = 0; k < 1024; ++k) s += uu[k] * P.w_ple_gate[(size_t)k * 1024 + n];
            for (int k = 0; k < 256; ++k) pe += P.p[r0 * 256 + k] * P.w_ple[(size_t)k * 1024 + n];
            x2[n] = x1[n] + pe / (1.f + expf(-s)); }
        __threadfence(); __syncthreads();
        if (tid == 0) { float ss = 0.f; for (int k = 0; k < 1024; ++k) ss += x2[k] * x2[k]; const float rs = rsqrtf(ss / 1024.f + EPS); float md = 0.f, mx = 0.f;
            for (int k = 0; k < 1024; ++k) { const float e = x2[k] * rs * P.g_final[k]; md = fmaxf(md, fabsf(e - P.out[r0 * 1024 + k])); mx = fmaxf(mx, fabsf(e)); }
            if (md / mx > 0.05f) { atomicAdd((unsigned*)(ws + 500 * MiB), 1u); atomicMax((unsigned*)(ws + 500 * MiB) + 64, (unsigned)blockIdx.x + 1u); } }
        __threadfence(); __syncthreads();
    }
    GRID_SYNC();
    { const int tid = fresh_tid(); const float cst = (float)__hip_atomic_load((const unsigned*)(ws + 500 * MiB) + DIAG13_WHICH * 64, __ATOMIC_RELAXED, __HIP_MEMORY_SCOPE_AGENT);
      for (size_t i = (size_t)blockIdx.x * 512 + tid; i < (size_t)NTOK * 1024; i += (size_t)G * 512) P.out[i] = cst; }
#endif
#if DIAG == 20
    STAMP(9);
    GRID_SYNC();
    { const int tid = fresh_tid(); const unsigned long long* TS = (const unsigned long long*)(P.ws + 500 * MiB + 8192);
      const unsigned long long ta = __hip_atomic_load(TS + 0, __ATOMIC_RELAXED, __HIP_MEMORY_SCOPE_AGENT), tb = __hip_atomic_load(TS + 9, __ATOMIC_RELAXED, __HIP_MEMORY_SCOPE_AGENT);
      const unsigned long long t0 = __hip_atomic_load(TS + DIAG_T, __ATOMIC_RELAXED, __HIP_MEMORY_SCOPE_AGENT), t1 = __hip_atomic_load(TS + DIAG_T + 1, __ATOMIC_RELAXED, __HIP_MEMORY_SCOPE_AGENT);
      const float cst = floorf(99.f * (float)(t1 - t0) / (float)(tb - ta));
      for (size_t i = (size_t)blockIdx.x * 512 + tid; i < (size_t)NTOK * 1024; i += (size_t)G * 512) P.out[i] = cst; }
#endif
}

extern "C" void kernel_launch(void* const* d_in, const int* in_sizes, int n_in, void* d_out, int out_size, void* d_ws, size_t ws_size, hipStream_t stream) {
    static int grid = 0;
    if (grid == 0) {
        int dev = 0, cus = 0, per_cu = 0;
        hipGetDevice(&dev);
        hipDeviceGetAttribute(&cus, hipDeviceAttributeMultiprocessorCount, dev);
        hipFuncSetAttribute((const void*)fwd_kernel, hipFuncAttributeMaxDynamicSharedMemorySize, LDS_BYTES);
        hipOccupancyMaxActiveBlocksPerMultiprocessor(&per_cu, (const void*)fwd_kernel, 512, LDS_BYTES);
        if (per_cu < 1) per_cu = 1;
        grid = cus * per_cu;
        if (ws_size < 460 * MiB) fprintf(stderr, "kernel_launch: workspace too small: %zu\n", ws_size);
    }
#if !USE_CG_SYNC
    (void)hipMemsetAsync(d_ws, 0, 1 << 20, stream);
#endif
    Params p{};
    p.x = (const float*)d_in[0]; p.p = (const float*)d_in[1]; p.g_mix = (const float*)d_in[2]; p.w_in = (const float*)d_in[3];
    p.w_alpha = (const float*)d_in[4]; p.b_alpha = (const float*)d_in[5]; p.g_gla = (const float*)d_in[6]; p.w_out_gla = (const float*)d_in[7];
    p.w_out_sb = (const float*)d_in[8]; p.w_out = (const float*)d_in[9]; p.g_ple = (const float*)d_in[10]; p.w_ple_gate = (const float*)d_in[11];
    p.w_ple = (const float*)d_in[12]; p.g_final = (const float*)d_in[13];
    p.out = (float*)d_out; p.ws = (unsigned char*)d_ws;
#if N_LAUNCHES == 1
    p.ph_lo = 0; p.ph_hi = 9;
    void* args[] = {&p};
    hipError_t e = hipLaunchCooperativeKernel((const void*)fwd_kernel, dim3(grid), dim3(512), args, LDS_BYTES, stream);
    if (e != hipSuccess) fprintf(stderr, "cooperative launch failed: %s (grid %d)\n", hipGetErrorString(e), grid);
#else
    for (int k = 0; k < 9; ++k) { p.ph_lo = k; p.ph_hi = k + 1; hipLaunchKernelGGL(fwd_kernel, dim3(grid), dim3(512), LDS_BYTES, stream, p); }
#endif
}
```
